# Optimizing an MI355X kernel written in HIP

```python
import jax
import jax.numpy as jnp
from jax import lax
import numpy as np

D_MODEL = 1024
BATCH = 32
SEQ = 256
DEPTH = 2
DEC_BATCH = 2
DEC_SEQ = 2048
PAST_LEN = 256

GRID_W = 64
Q_BLOCK = 128
ROPE_THETA = 10000.0
EPS = 1e-6
GATE_FLOOR = 1e-30
HG_HEADS = 4
HG_DK = 64
HG_DV = 64
HG_CHUNK = 16
MLA_HEADS = 6
MLA_NOPE = 64
MLA_ROPE = 32
MLA_V = 64
MLA_Q_RANK = 256
MLA_KV_RANK = 128
GQA_HEADS = 6
GQA_KV_HEADS = 2
GQA_GROUP = GQA_HEADS // GQA_KV_HEADS
GQA_HD = 64
HG_W = HG_HEADS * HG_DV
MLA_W = MLA_HEADS * MLA_V
GQA_W = GQA_HEADS * GQA_HD
MIX_W = HG_W + MLA_W + GQA_W
D_FF = -(-8 * D_MODEL // (3 * 256)) * 256
MLA_SCALE = (MLA_NOPE + MLA_ROPE) ** -0.5
GQA_SCALE = GQA_HD ** -0.5
ALPHA = (2 * DEPTH) ** 0.25
BETA = (8 * DEPTH) ** -0.25
IN_SIZES = (HG_HEADS * HG_DK, HG_HEADS * HG_DK, HG_HEADS * HG_DK, HG_HEADS * HG_DV, HG_HEADS * HG_DV,
            MLA_Q_RANK, MLA_KV_RANK, MLA_ROPE,
            GQA_HEADS * GQA_HD, GQA_KV_HEADS * GQA_HD, GQA_KV_HEADS * GQA_HD)
IN_OFFSETS = tuple(sum(IN_SIZES[:i + 1]) for i in range(len(IN_SIZES) - 1))
N_IN = sum(IN_SIZES)

kernel_name = "hymba_dit_prefix_denoise_step"

F32 = jnp.float32


def _rms(x, g):
    xf = x.astype(F32)
    y = xf * lax.rsqrt(jnp.mean(xf * xf, axis=-1, keepdims=True) + EPS)
    return (y * g.astype(F32)).astype(x.dtype)


def _layernorm(x, g, b):
    xf = x.astype(F32)
    xc = xf - jnp.mean(xf, axis=-1, keepdims=True)
    var = jnp.mean(xc * xc, axis=-1, keepdims=True)
    return (xc * lax.rsqrt(var + EPS) * g.astype(F32) + b.astype(F32)).astype(x.dtype)


def _grid_positions(n):
    rows = n // GRID_W
    row = jnp.repeat(jnp.arange(rows, dtype=F32), GRID_W)
    col = jnp.tile(jnp.arange(GRID_W, dtype=F32), rows)
    return row, col


def _rope_1d(x, pos):
    half = x.shape[-1] // 2
    freqs = ROPE_THETA ** (-jnp.arange(half, dtype=F32) / half)
    ang = pos[:, None] * freqs[None, :]
    cos = jnp.cos(ang)[None, :, None, :]
    sin = jnp.sin(ang)[None, :, None, :]
    xf = x.astype(F32)
    x1, x2 = xf[..., :half], xf[..., half:]
    return jnp.concatenate([x1 * cos - x2 * sin, x1 * sin + x2 * cos], axis=-1).astype(x.dtype)


def _rope_2d(x, row, col):
    r = x.shape[-1] // 2
    return jnp.concatenate([_rope_1d(x[..., :r], row), _rope_1d(x[..., r:], col)], axis=-1)


def _attention(q, k, v, scale):
    b, sq, kh, g, dk = q.shape
    nb = sq // Q_BLOCK
    qb = q.reshape(b, nb, Q_BLOCK, kh, g, dk).swapaxes(0, 1)

    def one_block(qi):
        s = jnp.einsum('bqhgd,bkhd->bhgqk', qi, k, preferred_element_type=F32) * scale
        p = jax.nn.softmax(s, axis=-1)
        return jnp.einsum('bhgqk,bkhe->bqhge', p.astype(v.dtype), v)

    out = lax.map(one_block, qb)
    return out.swapaxes(0, 1).reshape(b, sq, kh, g, v.shape[-1])


def _hgrn_scan(q, logf, k, i, s0):
    b, s, h, dk = q.shape
    dv = i.shape[-1]
    n = s // HG_CHUNK

    def chunk(t):
        return t.reshape(b, n, HG_CHUNK, h, t.shape[-1]).transpose(1, 0, 3, 2, 4)

    qc, lc, kc, ic = chunk(q), chunk(logf), chunk(k), chunk(i)
    bc = jnp.cumsum(lc, axis=3)
    causal = jnp.tril(jnp.ones((HG_CHUNK, HG_CHUNK), dtype=bool))[:, :, None]
    diff = bc[..., :, None, :] - bc[..., None, :, :]
    decay = jnp.where(causal, jnp.exp(jnp.where(causal, diff, 0.0)), 0.0)
    a = jnp.einsum('nbhtk,nbhtsk,nbhsk->nbhts', qc, decay, kc)
    intra = jnp.einsum('nbhts,nbhsv->nbhtv', a, ic)
    q_dec = qc * jnp.exp(bc)
    k_dec = kc * jnp.exp(bc[..., -1:, :] - bc)
    chunk_decay = jnp.exp(bc[..., -1, :])

    def step(S, xs):
        qd, kd, iv, cd = xs
        inter = jnp.einsum('bhtk,bhkv->bhtv', qd, S)
        S = S * cd[..., None] + jnp.einsum('bhsk,bhsv->bhkv', kd, iv)
        return S, inter

    s_final, inter = lax.scan(step, s0, (q_dec, k_dec, ic, chunk_decay))
    o = (intra + inter).transpose(1, 0, 3, 2, 4).reshape(b, s, h, dv)
    return o, s_final


def _hgrn_mixer(hq, hff, hfb, hi, hg, lb, s0f, s0b, norm_g):
    b, s, _ = hq.shape
    q = jax.nn.silu(hq.astype(F32)).reshape(b, s, HG_HEADS, HG_DK) * (HG_DK ** -0.5)
    i = hi.astype(F32).reshape(b, s, HG_HEADS, HG_DV)

    def gates(z, lbd):
        z = z.astype(F32).reshape(b, s, HG_HEADS, HG_DK)
        lbd = lbd.reshape(HG_HEADS, HG_DK)
        f = lbd + (1.0 - lbd) * jax.nn.sigmoid(z)
        return jnp.log(jnp.maximum(f, GATE_FLOOR)), (1.0 - lbd) * jax.nn.sigmoid(-z)

    lf, kf = gates(hff, lb[0])
    lbw, kb = gates(hfb, lb[1])
    o_f, s_f = _hgrn_scan(q, lf, kf, i, s0f)
    flip = lambda t: jnp.flip(t, axis=1)
    o_b, s_b = _hgrn_scan(flip(q), flip(lbw), flip(kb), flip(i), s0b)
    o = _rms(o_f + flip(o_b), norm_g) * jax.nn.silu(hg.astype(F32).reshape(b, s, HG_HEADS, HG_DV))
    return o.reshape(b, s, HG_W).astype(hq.dtype), s_f, s_b


def _mla_queries(mq, q_norm, w_uq):
    b, s, _ = mq.shape
    q = jnp.einsum('bsr,rn->bsn', _rms(mq, q_norm), w_uq).reshape(b, s, MLA_HEADS, MLA_NOPE + MLA_ROPE)
    return q[..., :MLA_NOPE], q[..., MLA_NOPE:]


def _mla_keys_values(ckv, kpe, w_ukv):
    b, s, _ = ckv.shape
    kv = jnp.einsum('bsr,rn->bsn', ckv, w_ukv).reshape(b, s, MLA_HEADS, MLA_NOPE + MLA_V)
    kpe_h = jnp.broadcast_to(kpe[:, :, None, :], (b, s, MLA_HEADS, MLA_ROPE))
    return jnp.concatenate([kv[..., :MLA_NOPE], kpe_h], axis=-1), kv[..., MLA_NOPE:]


def _mixer(h, P, l, lb, cache):
    b, s, _ = h.shape
    z = jnp.einsum('bsd,dn->bsn', h, P['w_in'][l])
    hq, hff, hfb, hi, hg, mq, mkv, mkr, gq, gk, gv = jnp.split(z, IN_OFFSETS, axis=-1)
    is_ctx = cache is None
    if is_ctx:
        s0f = jnp.zeros((b, HG_HEADS, HG_DK, HG_DV), F32)
        s0b = s0f
    else:
        ckv_c, kpe_c, gk_c, gv_c, st_c = cache
        s0f, s0b = st_c[:, 0].astype(F32), st_c[:, 1].astype(F32)
    hg_out, s_f, s_b = _hgrn_mixer(hq, hff, hfb, hi, hg, lb, s0f, s0b, P['hg_norm'][l])

    q_nope, q_pe = _mla_queries(mq, P['mla_q_norm'][l], P['mla_w_uq'][l])
    ckv = _rms(mkv, P['mla_kv_norm'][l])
    kpe = mkr
    gq = _rms(gq.reshape(b, s, GQA_HEADS, GQA_HD), P['gqa_q_norm'][l])
    gk = _rms(gk.reshape(b, s, GQA_KV_HEADS, GQA_HD), P['gqa_k_norm'][l])
    gv = gv.reshape(b, s, GQA_KV_HEADS, GQA_HD)
    w_ukv = P['mla_w_ukv'][l]
    if is_ctx:
        mk, mv = _mla_keys_values(ckv, kpe, w_ukv)
        ak, av = gk, gv
        new = (ckv, kpe, gk, gv, jnp.stack([s_f, s_b], axis=1).astype(h.dtype))
    else:
        row, col = _grid_positions(s)
        q_pe = _rope_2d(q_pe, row, col)
        kpe_rot = _rope_2d(kpe[:, :, None, :], row, col)[:, :, 0, :]
        mk_l, mv_l = _mla_keys_values(ckv, kpe_rot, w_ukv)
        mk_c, mv_c = _mla_keys_values(ckv_c, kpe_c, w_ukv)
        mk = jnp.concatenate([mk_c, mk_l], axis=1)
        mv = jnp.concatenate([mv_c, mv_l], axis=1)
        gq = _rope_2d(gq, row, col)
        ak = jnp.concatenate([gk_c, _rope_2d(gk, row, col)], axis=1)
        av = jnp.concatenate([gv_c, gv], axis=1)
        new = None
    mla_q = jnp.concatenate([q_nope, q_pe], axis=-1)[:, :, :, None, :]
    mla_out = _attention(mla_q, mk, mv, MLA_SCALE).reshape(b, s, MLA_W)
    gqa_out = _attention(gq.reshape(b, s, GQA_KV_HEADS, GQA_GROUP, GQA_HD), ak, av, GQA_SCALE).reshape(b, s, GQA_W)
    mixed = jnp.concatenate([hg_out, mla_out, gqa_out], axis=-1)
    return jnp.einsum('bsn,nd->bsd', mixed, P['w_out'][l]), new


def _layer(x, cvec, P, l, lb, cache):
    m = jnp.einsum('bd,dn->bn', jax.nn.silu(cvec), P['w_ada'][l]) + P['b_ada'][l]
    sh1, sc1, g1, sh2, sc2, g2 = jnp.split(m[:, None, :], 6, axis=-1)
    y, new = _mixer(x * (1.0 + sc1) + sh1, P, l, lb, cache)
    x = _layernorm(ALPHA * x + g1 * y, P['ln1_g'][l], P['ln1_b'][l])
    hf = x * (1.0 + sc2) + sh2
    gate, up = jnp.split(jnp.einsum('bsd,dn->bsn', hf, P['w_ffn_in'][l]), 2, axis=-1)
    f = jnp.einsum('bsn,nd->bsd', jax.nn.silu(gate) * up, P['w_ffn_out'][l])
    x = _layernorm(ALPHA * x + g2 * f, P['ln2_g'][l], P['ln2_b'][l])
    return x, new


def setup_inputs(seed: int = 0) -> dict:
    key = jax.random.key(seed)
    ks = jax.random.split(key, 32)
    nrm = lambda k, shape, sc: jax.random.normal(k, shape, jnp.float32) * sc
    gain = lambda k, shape: 1.0 + nrm(k, shape, 0.02)
    D = D_MODEL
    return {
        'x_prompt': nrm(ks[0], (BATCH, SEQ, D), 1.0),
        'x_sample': nrm(ks[1], (DEC_BATCH, DEC_SEQ, D), 1.0),
        'cache_mla_ckv': nrm(ks[2], (DEC_BATCH, DEPTH, PAST_LEN, MLA_KV_RANK), 1.0),
        'cache_mla_kpe': nrm(ks[3], (DEC_BATCH, DEPTH, PAST_LEN, MLA_ROPE), 1.0),
        'cache_gqa_k': nrm(ks[4], (DEC_BATCH, DEPTH, PAST_LEN, GQA_KV_HEADS, GQA_HD), 1.0),
        'cache_gqa_v': nrm(ks[5], (DEC_BATCH, DEPTH, PAST_LEN, GQA_KV_HEADS, GQA_HD), 1.0),
        'state_hgrn': nrm(ks[6], (DEC_BATCH, DEPTH, 2, HG_HEADS, HG_DK, HG_DV), 0.5),
        'c': nrm(ks[7], (DEC_BATCH, D), 1.0),
        'c_ctx': nrm(ks[8], (D,), 1.0),
        'w_ada': nrm(ks[9], (DEPTH, D, 6 * D), 0.5 * D ** -0.5),
        'b_ada': nrm(ks[10], (DEPTH, 6 * D), 0.02),
        'w_in': nrm(ks[11], (DEPTH, D, N_IN), D ** -0.5),
        'hg_lb': nrm(ks[12], (DEPTH, 2, HG_HEADS * HG_DK), 0.5),
        'hg_norm': gain(ks[13], (DEPTH, HG_DV)),
        'mla_q_norm': gain(ks[14], (DEPTH, MLA_Q_RANK)),
        'mla_w_uq': nrm(ks[15], (DEPTH, MLA_Q_RANK, MLA_HEADS * (MLA_NOPE + MLA_ROPE)), MLA_Q_RANK ** -0.5),
        'mla_kv_norm': gain(ks[16], (DEPTH, MLA_KV_RANK)),
        'mla_w_ukv': nrm(ks[17], (DEPTH, MLA_KV_RANK, MLA_HEADS * (MLA_NOPE + MLA_V)), MLA_KV_RANK ** -0.5),
        'gqa_q_norm': gain(ks[18], (DEPTH, GQA_HD)),
        'gqa_k_norm': gain(ks[19], (DEPTH, GQA_HD)),
        'w_out': nrm(ks[20], (DEPTH, MIX_W, D), BETA * MIX_W ** -0.5),
        'ln1_g': gain(ks[21], (DEPTH, D)),
        'ln1_b': nrm(ks[22], (DEPTH, D), 0.02),
        'w_ffn_in': nrm(ks[23], (DEPTH, D, 2 * D_FF), D ** -0.5),
        'w_ffn_out': nrm(ks[24], (DEPTH, D_FF, D), BETA * D_FF ** -0.5),
        'ln2_g': gain(ks[25], (DEPTH, D)),
        'ln2_b': nrm(ks[26], (DEPTH, D), 0.02),
    }


def reference(x_prompt, x_sample, cache_mla_ckv, cache_mla_kpe, cache_gqa_k, cache_gqa_v, state_hgrn, c, c_ctx,
              w_ada, b_ada, w_in, hg_lb, hg_norm, mla_q_norm, mla_w_uq, mla_kv_norm, mla_w_ukv,
              gqa_q_norm, gqa_k_norm, w_out, ln1_g, ln1_b, w_ffn_in, w_ffn_out, ln2_g, ln2_b):
    P = {'w_ada': w_ada, 'b_ada': b_ada, 'w_in': w_in, 'hg_norm': hg_norm,
         'mla_q_norm': mla_q_norm, 'mla_w_uq': mla_w_uq, 'mla_kv_norm': mla_kv_norm, 'mla_w_ukv': mla_w_ukv,
         'gqa_q_norm': gqa_q_norm, 'gqa_k_norm': gqa_k_norm, 'w_out': w_out,
         'ln1_g': ln1_g, 'ln1_b': ln1_b, 'w_ffn_in': w_ffn_in, 'w_ffn_out': w_ffn_out,
         'ln2_g': ln2_g, 'ln2_b': ln2_b}
    sm = jax.nn.softmax(hg_lb.astype(F32), axis=0)
    lbs = jnp.cumsum(sm, axis=0) - sm[0:1]

    x = x_prompt
    news = []
    for l in range(DEPTH):
        x, new = _layer(x, c_ctx[None, :], P, l, lbs[l], None)
        news.append(new)
    y_prompt = x
    state_mla_ckv = jnp.stack([n[0] for n in news], axis=1)
    state_mla_kpe = jnp.stack([n[1] for n in news], axis=1)
    state_gqa_k = jnp.stack([n[2] for n in news], axis=1)
    state_gqa_v = jnp.stack([n[3] for n in news], axis=1)
    new_state_hgrn = jnp.stack([n[4] for n in news], axis=1)

    x = x_sample
    for l in range(DEPTH):
        cache = (cache_mla_ckv[:, l], cache_mla_kpe[:, l], cache_gqa_k[:, l], cache_gqa_v[:, l], state_hgrn[:, l])
        x, _ = _layer(x, c, P, l, lbs[l], cache)
    y_sample = x
    return (y_prompt, y_sample, state_mla_ckv, state_mla_kpe, state_gqa_k, state_gqa_v, new_state_hgrn)
```

```cpp
#include <hip/hip_runtime.h>
#include <hip/hip_cooperative_groups.h>
#include <cstdio>
namespace cg = cooperative_groups;

#ifndef MULTI
#define MULTI 0
#endif


#define DI __device__ __forceinline__
typedef unsigned short bf16_t;
using bf16x8 = __attribute__((ext_vector_type(8))) short;
using f32x16 = __attribute__((ext_vector_type(16))) float;
using f32x32 = __attribute__((ext_vector_type(32))) float;
using f32x8 = __attribute__((ext_vector_type(8))) float;
using f32x4 = __attribute__((ext_vector_type(4))) float;
using u32x16 = __attribute__((ext_vector_type(16))) unsigned;
using u32x8 = __attribute__((ext_vector_type(8))) unsigned;
using u32x4 = __attribute__((ext_vector_type(4))) unsigned;
using u32x2 = __attribute__((ext_vector_type(2))) unsigned;
#define MFMA(a, b, c) __builtin_amdgcn_mfma_f32_32x32x16_bf16((a), (b), (c), 0, 0, 0)

constexpr int NTOK = 12288, NCTX = 8192, NKR = 12800;
constexpr int LDX = 1024 + 64, LDH = 2816 + 64;
constexpr float EPS = 1e-6f;
constexpr float ALPHA = 1.4142135623730951f;
constexpr float LOG2E = 1.4426950408889634f;
constexpr float MLA_QS = 0.10206207261596575f * LOG2E;
constexpr float GQA_QS = 0.125f * LOG2E;

constexpr size_t O_Y = 0;
constexpr size_t O_CKV = 12582912;
constexpr size_t O_KPE = 14680064;
constexpr size_t O_GK = 15204352;
constexpr size_t O_GV = 17301504;
constexpr size_t O_HG = 19398656;

constexpr size_t al(size_t x) { return (x + 255) & ~(size_t)255; }
constexpr size_t W_WIN = 0;
constexpr size_t W_WUQ = al(W_WIN + 2ull * 2560 * LDX * 2);
constexpr size_t W_WUKV = al(W_WUQ + 2ull * 768 * 256 * 2);
constexpr size_t W_WOUT = al(W_WUKV + 2ull * 768 * 128 * 2);
constexpr size_t W_WFI = al(W_WOUT + 2ull * 1024 * LDX * 2);
constexpr size_t W_WFO = al(W_WFI + 2ull * 5632 * LDX * 2);
constexpr size_t W_ADAP = al(W_WFO + 2ull * 1024 * LDH * 2);
constexpr size_t W_ADAM = al(W_ADAP + 16ull * 2 * 3 * 6144 * 4);
constexpr size_t W_GB = al(W_ADAM + 2ull * 3 * 6144 * 4);
constexpr size_t W_STA = al(W_GB + 2ull * 2 * 3 * 2048 * 4);
constexpr size_t W_STB = al(W_STA + 12288ull * 32 * 4);
constexpr size_t W_ZH = al(W_STB + 12288ull * 32 * 4);
constexpr size_t W_MQ = al(W_ZH + 12288ull * 1280 * 4);
constexpr size_t W_MQSS = al(W_MQ + 12288ull * 256 * 2);
constexpr size_t W_CKVB = al(W_MQSS + 12288ull * 2 * 4);
constexpr size_t W_ZEND = al(W_CKVB + 12800ull * 128 * 2);
constexpr size_t W_HID = W_ZH;
static_assert(W_ZEND - W_ZH >= 12288ull * LDH * 2, "hidden alias");
constexpr size_t W_QM = W_ZEND;
constexpr size_t W_KM = al(W_QM + 12288ull * 576 * 2);
constexpr size_t W_VMT = al(W_KM + 12800ull * 576 * 2);
constexpr size_t W_QG = al(W_VMT + 384ull * 12800 * 2);
constexpr size_t W_KG = al(W_QG + 12288ull * 384 * 2);
constexpr size_t W_VGT = al(W_KG + 12800ull * 128 * 2);
constexpr size_t W_HKV = al(W_VGT + 128ull * 12800 * 2);
constexpr size_t W_HCD = al(W_HKV + 1536ull * 4096 * 4);
constexpr size_t W_MIX = al(W_HCD + 1536ull * 64 * 4);
constexpr size_t W_END = al(W_MIX + 12288ull * LDX * 2);
constexpr size_t W_ROPE = W_END;
constexpr size_t W_BAR = al(W_ROPE + 3072 * 4);
constexpr size_t BAR_BYTES = 3456 * 4 + 1024;
static_assert(W_BAR + BAR_BYTES <= 268435456ull, "workspace");

struct Params {
  const float* in[27];
  float* out;
  char* ws;
};
enum { I_XP = 0, I_XS, I_CCKV, I_CKPE, I_CGK, I_CGV, I_SHG, I_C, I_CCTX, I_WADA, I_BADA, I_WIN, I_HGLB, I_HGN, I_MQN, I_WUQ,
       I_MKVN, I_WUKV, I_GQN, I_GKN, I_WOUT, I_LN1G, I_LN1B, I_WFI, I_WFO, I_LN2G, I_LN2B };

constexpr int SMEM_BYTES = 73728;
constexpr int CS = 132;

DI int get_tid512() { int t = __builtin_amdgcn_workitem_id_x(); asm volatile("" : "+v"(t)); return t; }
DI int get_tid() { return get_tid512() & 255; }
DI int get_half() { return __builtin_amdgcn_readfirstlane(get_tid512() >> 8); }
DI int vbid() { return (int)blockIdx.x * 2 + get_half(); }
DI int vgrid() { return (int)gridDim.x * 2; }
DI float ld_dev(const float* p) { return __hip_atomic_load(p, __ATOMIC_RELAXED, __HIP_MEMORY_SCOPE_AGENT); }
DI float bf2f(bf16_t x) { return __uint_as_float(((unsigned)x) << 16); }
DI unsigned f2bf(float x) {
  unsigned u = __float_as_uint(x);
  u += 0x7fffu + ((u >> 16) & 1u);
  return u >> 16;
}
typedef __bf16 bf16x2_t __attribute__((ext_vector_type(2)));
typedef float f32x2_t __attribute__((ext_vector_type(2)));
DI unsigned pack2(float a, float b) {
  f32x2_t v; v[0] = a; v[1] = b;
  return __builtin_bit_cast(unsigned, __builtin_convertvector(v, bf16x2_t));
}
DI float fexp2(float x) { return __builtin_amdgcn_exp2f(x); }
DI float flog2(float x) { return __builtin_amdgcn_logf(x); }
DI float frcp(float x) { return __builtin_amdgcn_rcpf(x); }
DI float fsigmoid(float x) { return frcp(1.f + fexp2(-x * 1.4426950408889634f)); }
DI float silu(float x) { return x * frcp(1.f + __builtin_amdgcn_exp2f(-x * 1.4426950408889634f)); }

DI void tokinfo(int t, int& v, int& b, int& s, int& kr) {
  if (t < NCTX) { v = 0; b = t >> 8; s = t & 255; kr = t; }
  else { int u = t - NCTX; b = u >> 11; s = u & 2047; v = 1 + b; kr = NCTX + b * 2304 + 256 + s; }
}

DI void gemm_core(const bf16_t* __restrict__ Ap, int lda, const bf16_t* __restrict__ Bp, int ldb, int K, char* smem) {
  const int tid = get_tid(), lane = tid & 63, w = tid >> 6, l32 = lane & 31, g = lane >> 5;
  const int wm = w >> 1, wn = w & 1;
  char* As = smem;
  char* Bs = smem + 18432;
  f32x16 acc[2][2];
#pragma unroll
  for (int i = 0; i < 2; ++i)
#pragma unroll
    for (int j = 0; j < 2; ++j)
#pragma unroll
      for (int e = 0; e < 16; ++e) acc[i][j][e] = 0.f;

  u32x16 rab, rb;
  const int kc8 = (tid & 7) * 8, r32 = tid >> 3;
  const int KT = K >> 6;
#define GEMM_PREFETCH(k0)                                                                                   \
  {                                                                                                         \
    _Pragma("unroll") for (int i = 0; i < 4; ++i) {                                                         \
      const u32x4 t = *(const u32x4*)(Ap + (size_t)(r32 + 32 * i) * lda + (k0) + kc8);                      \
      rab[i * 4 + 0] = t[0]; rab[i * 4 + 1] = t[1]; rab[i * 4 + 2] = t[2]; rab[i * 4 + 3] = t[3];           \
    }                                                                                                       \
    _Pragma("unroll") for (int i = 0; i < 4; ++i) {                                                         \
      const u32x4 t = *(const u32x4*)(Bp + (size_t)(r32 + 32 * i) * ldb + (k0) + kc8);                      \
      rb[i * 4 + 0] = t[0]; rb[i * 4 + 1] = t[1]; rb[i * 4 + 2] = t[2]; rb[i * 4 + 3] = t[3];               \
    }                                                                                                       \
  }
#define GEMM_STORE(buf)                                                                                     \
  {                                                                                                         \
    _Pragma("unroll") for (int i = 0; i < 4; ++i) {                                                         \
      u32x4 t; t[0] = rab[i * 4 + 0]; t[1] = rab[i * 4 + 1]; t[2] = rab[i * 4 + 2]; t[3] = rab[i * 4 + 3];  \
      *(u32x4*)(As + (buf) * 36864 + (r32 + 32 * i) * 144 + kc8 * 2) = t;                                   \
    }                                                                                                       \
    _Pragma("unroll") for (int i = 0; i < 4; ++i) {                                                         \
      u32x4 t; t[0] = rb[i * 4 + 0]; t[1] = rb[i * 4 + 1]; t[2] = rb[i * 4 + 2]; t[3] = rb[i * 4 + 3];      \
      *(u32x4*)(Bs + (buf) * 36864 + (r32 + 32 * i) * 144 + kc8 * 2) = t;                                   \
    }                                                                                                       \
  }
  GEMM_PREFETCH(0)
  GEMM_STORE(0)
  __syncthreads();
  for (int kt = 0; kt < KT; ++kt) {
    const int cur = kt & 1;
    if (kt + 1 < KT) {
      const int k0n = (kt + 1) << 6;
      GEMM_PREFETCH(k0n)
    }
    __builtin_amdgcn_sched_barrier(0);
    const char* Ac = As + cur * 36864;
    const char* Bc = Bs + cur * 36864;
#pragma unroll
    for (int ks = 0; ks < 4; ++ks) {
      const int ko = (ks * 16 + g * 8) * 2;
      bf16x8 a0 = *(const bf16x8*)(Ac + (wm * 64 + l32) * 144 + ko);
      bf16x8 a1 = *(const bf16x8*)(Ac + (wm * 64 + 32 + l32) * 144 + ko);
      bf16x8 b0 = *(const bf16x8*)(Bc + (wn * 64 + l32) * 144 + ko);
      bf16x8 b1 = *(const bf16x8*)(Bc + (wn * 64 + 32 + l32) * 144 + ko);
      acc[0][0] = MFMA(a0, b0, acc[0][0]);
      acc[0][1] = MFMA(a0, b1, acc[0][1]);
      acc[1][0] = MFMA(a1, b0, acc[1][0]);
      acc[1][1] = MFMA(a1, b1, acc[1][1]);
    }
    __builtin_amdgcn_sched_barrier(0);
    if (kt + 1 < KT) GEMM_STORE(cur ^ 1)
    __syncthreads();
  }
  float* Cs = (float*)smem;
#pragma unroll
  for (int mt = 0; mt < 2; ++mt)
#pragma unroll
    for (int nt = 0; nt < 2; ++nt)
#pragma unroll
      for (int j = 0; j < 16; ++j) {
        int row = wm * 64 + mt * 32 + (j & 3) + 8 * (j >> 2) + 4 * g;
        Cs[row * CS + wn * 64 + nt * 32 + l32] = acc[mt][nt][j];
      }
  __syncthreads();
}


constexpr int STG = 73728;
template <int MT>
DI void gemm512_main(const bf16_t* __restrict__ Ap, int lda, const bf16_t* __restrict__ Bp, int ldb, int K, char* smem,
                     f32x16 (&acc)[MT][2]) {
  const int tid = get_tid512(), lane = tid & 63, w = tid >> 6, l32 = lane & 31, g = lane >> 5;
  const int wm = w >> 2, wn = w & 3;
#pragma unroll
  for (int i = 0; i < MT; ++i)
#pragma unroll
    for (int j = 0; j < 2; ++j)
#pragma unroll
      for (int e = 0; e < 16; ++e) acc[i][j][e] = 0.f;
  u32x16 ra, rb;
  const int kc8 = (tid & 7) * 8, r64 = tid >> 3;
  const int KT = K >> 6;
  const unsigned aoff = (unsigned)(r64 * lda + kc8) * 2u, astep = (unsigned)(64 * lda) * 2u;
  const unsigned boff = (unsigned)(r64 * ldb + kc8) * 2u, bstep = (unsigned)(64 * ldb) * 2u;
#define G512_PREFETCH(k0)                                                                                   \
  {                                                                                                         \
    _Pragma("unroll") for (int i = 0; i < MT; ++i) {                                                        \
      const u32x4 t = *(const u32x4*)(Ap + (size_t)(r64 + 64 * i) * lda + (k0) + kc8);                      \
      ra[i * 4 + 0] = t[0]; ra[i * 4 + 1] = t[1]; ra[i * 4 + 2] = t[2]; ra[i * 4 + 3] = t[3];               \
    }                                                                                                       \
    _Pragma("unroll") for (int i = 0; i < 4; ++i) {                                                         \
      const u32x4 t = *(const u32x4*)(Bp + (size_t)(r64 + 64 * i) * ldb + (k0) + kc8);                      \
      rb[i * 4 + 0] = t[0]; rb[i * 4 + 1] = t[1]; rb[i * 4 + 2] = t[2]; rb[i * 4 + 3] = t[3];               \
    }                                                                                                       \
  }
#define G512_STORE(buf)                                                                                     \
  {                                                                                                         \
    _Pragma("unroll") for (int i = 0; i < MT; ++i) {                                                        \
      u32x4 t; t[0] = ra[i * 4 + 0]; t[1] = ra[i * 4 + 1]; t[2] = ra[i * 4 + 2]; t[3] = ra[i * 4 + 3];      \
      *(u32x4*)(smem + (buf) * STG + (r64 + 64 * i) * 144 + kc8 * 2) = t;                                   \
    }                                                                                                       \
    _Pragma("unroll") for (int i = 0; i < 4; ++i) {                                                         \
      u32x4 t; t[0] = rb[i * 4 + 0]; t[1] = rb[i * 4 + 1]; t[2] = rb[i * 4 + 2]; t[3] = rb[i * 4 + 3];      \
      *(u32x4*)(smem + (buf) * STG + 36864 + (r64 + 64 * i) * 144 + kc8 * 2) = t;                           \
    }                                                                                                       \
  }
#define G512_LOAD_PART(i, k0)                                                                               \
  {                                                                                                         \
    if ((i) < MT) {                                                                                         \
    const u32x4 ta = *(const u32x4*)((const char*)Ap + (size_t)(unsigned)((k0) * 2) + (aoff + (unsigned)(i) * astep)); \
    ra[(i) * 4 + 0] = ta[0]; ra[(i) * 4 + 1] = ta[1]; ra[(i) * 4 + 2] = ta[2]; ra[(i) * 4 + 3] = ta[3]; }   \
    const u32x4 tb = *(const u32x4*)((const char*)Bp + (size_t)(unsigned)((k0) * 2) + (boff + (unsigned)(i) * bstep)); \
    rb[(i) * 4 + 0] = tb[0]; rb[(i) * 4 + 1] = tb[1]; rb[(i) * 4 + 2] = tb[2]; rb[(i) * 4 + 3] = tb[3];     \
  }
#define G512_STORE_PART(i, buf)                                                                             \
  {                                                                                                         \
    if ((i) < MT) {                                                                                         \
    u32x4 ta; ta[0] = ra[(i) * 4 + 0]; ta[1] = ra[(i) * 4 + 1]; ta[2] = ra[(i) * 4 + 2]; ta[3] = ra[(i) * 4 + 3]; \
    *(u32x4*)(smem + (buf) * STG + (r64 + 64 * (i)) * 144 + kc8 * 2) = ta; }                                \
    u32x4 tb; tb[0] = rb[(i) * 4 + 0]; tb[1] = rb[(i) * 4 + 1]; tb[2] = rb[(i) * 4 + 2]; tb[3] = rb[(i) * 4 + 3]; \
    *(u32x4*)(smem + (buf) * STG + 36864 + (r64 + 64 * (i)) * 144 + kc8 * 2) = tb;                          \
  }
  G512_PREFETCH(0)
  G512_STORE(0)
  if (KT > 1) { G512_PREFETCH(64) }
  __syncthreads();
  for (int kt = 0; kt < KT; ++kt) {
    const int cur = kt & 1;
    const char* Ac = smem + cur * STG;
    const char* Bc = Ac + 36864;
    bf16x8 fa[MT], fb0, fb1;
    const char* Ar = Ac + (wm * (MT * 32) + l32) * 144 + g * 16;
    const char* Br = Bc + (wn * 64 + l32) * 144 + g * 16;
#pragma unroll
    for (int mt = 0; mt < MT; ++mt) fa[mt] = *(const bf16x8*)(Ar + mt * 32 * 144);
    fb0 = *(const bf16x8*)(Br);
    fb1 = *(const bf16x8*)(Br + 32 * 144);
#pragma unroll
    for (int ks = 0; ks < 4; ++ks) {
#pragma unroll
      for (int mt = 0; mt < MT; ++mt) {
        acc[mt][0] = MFMA(fa[mt], fb0, acc[mt][0]);
        acc[mt][1] = MFMA(fa[mt], fb1, acc[mt][1]);
        if (ks < 3) fa[mt] = *(const bf16x8*)(Ar + mt * 32 * 144 + (ks + 1) * 32);
      }
      if (ks < 3) {
        fb0 = *(const bf16x8*)(Br + (ks + 1) * 32);
        fb1 = *(const bf16x8*)(Br + 32 * 144 + (ks + 1) * 32);
      }
      if (kt + 1 < KT) G512_STORE_PART(ks, cur ^ 1)
      if (kt + 2 < KT) { const int k0n = (kt + 2) << 6; G512_LOAD_PART(ks, k0n) }
      __builtin_amdgcn_sched_barrier(0);
    }
    __syncthreads();
  }
}
template <int MT>
DI void gemm512_stage(const f32x16 (&acc)[MT][2], int h, char* smem) {
  const int tid = get_tid512(), lane = tid & 63, w = tid >> 6, l32 = lane & 31, g = lane >> 5;
  const int wm = w >> 2, wn = w & 3;
  if (wm == h) {
    float* Cs = (float*)(smem + (wn >> 1) * STG);
#pragma unroll
    for (int mt = 0; mt < MT; ++mt)
#pragma unroll
      for (int nt = 0; nt < 2; ++nt)
#pragma unroll
        for (int j = 0; j < 16; ++j) {
          const int row = mt * 32 + (j & 3) + 8 * (j >> 2) + 4 * g;
          Cs[row * CS + (wn & 1) * 64 + nt * 32 + l32] = acc[mt][nt][j];
        }
  }
  __syncthreads();
}
struct TileWalk512 {
  int x, nb, mtx, total, q;
  DI TileWalk512(int MT, int NT) {
    x = blockIdx.x & 7; nb = gridDim.x >> 3;
    mtx = (MT - x + 7) >> 3; total = mtx * NT; q = blockIdx.x >> 3;
  }
  DI bool next(int& mt, int& nt) {
    if (q >= total) return false;
    mt = (q % mtx) * 8 + x; nt = q / mtx; q += nb;
    return true;
  }
};

DI float4 rope4(float4 v, float4 pv, int i0, bool first, int pos, const float* __restrict__ tab, int half) {
  const float4 cs = *(const float4*)(tab + pos * half + i0);
  const float4 sn = *(const float4*)(tab + 64 * half + pos * half + i0);
  float4 o;
  if (first) { o.x = v.x * cs.x - pv.x * sn.x; o.y = v.y * cs.y - pv.y * sn.y; o.z = v.z * cs.z - pv.z * sn.z; o.w = v.w * cs.w - pv.w * sn.w; }
  else { o.x = pv.x * sn.x + v.x * cs.x; o.y = pv.y * sn.y + v.y * cs.y; o.z = pv.z * sn.z + v.z * cs.z; o.w = pv.w * sn.w + v.w * cs.w; }
  return o;
}
DI float4 rope4cs(float4 v, float4 pv, bool first, float4 cs, float4 sn) {
  float4 o;
  if (first) { o.x = v.x * cs.x - pv.x * sn.x; o.y = v.y * cs.y - pv.y * sn.y; o.z = v.z * cs.z - pv.z * sn.z; o.w = v.w * cs.w - pv.w * sn.w; }
  else { o.x = pv.x * sn.x + v.x * cs.x; o.y = pv.y * sn.y + v.y * cs.y; o.z = pv.z * sn.z + v.z * cs.z; o.w = pv.w * sn.w + v.w * cs.w; }
  return o;
}
DI float4 shfl4(float4 v, int m) {
  return make_float4(__shfl_xor(v.x, m), __shfl_xor(v.y, m), __shfl_xor(v.z, m), __shfl_xor(v.w, m));
}
DI void store_bf4(bf16_t* dst, float4 v) {
  uint2 pk; pk.x = pack2(v.x, v.y); pk.y = pack2(v.z, v.w);
  *(uint2*)dst = pk;
}

struct WpDesc { int mat, K, Nsrc, ldw, k0, n0, l; const float* W; bf16_t* WT; };
DI WpDesc wprep_decode(const Params& p, int item) {
  WpDesc d;
  int l = item / 3048, rem = item % 3048;
  int Np, NT;
  if (rem < 608) { d.mat = 0; d.K = 1024; Np = 2560; d.Nsrc = 2336; NT = 38; d.W = p.in[I_WIN]; d.WT = (bf16_t*)(p.ws + W_WIN); d.ldw = LDX; }
  else if ((rem -= 608) < 48) { d.mat = 1; d.K = 256; Np = 768; d.Nsrc = 576; NT = 12; d.W = p.in[I_WUQ]; d.WT = (bf16_t*)(p.ws + W_WUQ); d.ldw = 256; }
  else if ((rem -= 48) < 24) { d.mat = 2; d.K = 128; Np = 768; d.Nsrc = 768; NT = 12; d.W = p.in[I_WUKV]; d.WT = (bf16_t*)(p.ws + W_WUKV); d.ldw = 128; }
  else if ((rem -= 24) < 256) { d.mat = 3; d.K = 1024; Np = 1024; d.Nsrc = 1024; NT = 16; d.W = p.in[I_WOUT]; d.WT = (bf16_t*)(p.ws + W_WOUT); d.ldw = LDX; }
  else if ((rem -= 256) < 1408) { d.mat = 4; d.K = 1024; Np = 5632; d.Nsrc = 5632; NT = 88; d.W = p.in[I_WFI]; d.WT = (bf16_t*)(p.ws + W_WFI); d.ldw = LDX; }
  else { rem -= 1408; d.mat = 5; d.K = 2816; Np = 1024; d.Nsrc = 1024; NT = 16; d.W = p.in[I_WFO]; d.WT = (bf16_t*)(p.ws + W_WFO); d.ldw = LDH; }
  d.k0 = (rem / NT) * 64; d.n0 = (rem % NT) * 64; d.l = l;
  d.W += (size_t)l * d.K * d.Nsrc;
  d.WT += (size_t)l * Np * d.ldw;
  return d;
}
DI int wprep_src(int mat, int n) {
  if (mat == 0) return (n < 1664) ? n : (n < 2304 ? n + 32 : (n < 2336 ? n - 640 : -1));
  if (mat == 1) { int h = n >> 7, jj = n & 127; return (jj < 96) ? h * 96 + jj : -1; }
  if (mat == 4) { int q = n >> 6, ww = n & 63; return (ww < 32) ? q * 32 + ww : 2816 + q * 32 + ww - 32; }
  return n;
}
DI void wprep_pair(const Params& p, int item, char* smem) {
  const int tid = get_tid();
  float* tile = (float*)smem;
  const WpDesc d0 = wprep_decode(p, item), d1 = wprep_decode(p, item + 1);
  const int j = tid & 63, i0 = tid >> 6;
  const int s0 = wprep_src(d0.mat, d0.n0 + j), s1 = wprep_src(d1.mat, d1.n0 + j);
  f32x16 v0, v1;
#pragma unroll
  for (int ps = 0; ps < 16; ++ps) {
    const int i = i0 + 4 * ps;
    v0[ps] = (s0 >= 0) ? d0.W[(size_t)(d0.k0 + i) * d0.Nsrc + s0] : 0.f;
  }
#pragma unroll
  for (int ps = 0; ps < 16; ++ps) {
    const int i = i0 + 4 * ps;
    v1[ps] = (s1 >= 0) ? d1.W[(size_t)(d1.k0 + i) * d1.Nsrc + s1] : 0.f;
  }
#pragma unroll
  for (int ps = 0; ps < 16; ++ps) {
    const int i = i0 + 4 * ps;
    float a = v0[ps], b = v1[ps];
    if (d0.mat == 1) a *= p.in[I_MQN][d0.l * 256 + d0.k0 + i];
    if (d1.mat == 1) b *= p.in[I_MQN][d1.l * 256 + d1.k0 + i];
    tile[i * 65 + j] = a;
    tile[4160 + i * 65 + j] = b;
  }
  __syncthreads();
  {
    const int ik2 = (tid & 31) * 2;
#pragma unroll
    for (int ps = 0; ps < 8; ++ps) {
      const int jn = (tid >> 5) + 8 * ps;
      *(unsigned*)(d0.WT + (size_t)(d0.n0 + jn) * d0.ldw + d0.k0 + ik2) = pack2(tile[ik2 * 65 + jn], tile[(ik2 + 1) * 65 + jn]);
      *(unsigned*)(d1.WT + (size_t)(d1.n0 + jn) * d1.ldw + d1.k0 + ik2) = pack2(tile[4160 + ik2 * 65 + jn], tile[4160 + (ik2 + 1) * 65 + jn]);
    }
  }
  __syncthreads();
}

DI void ada_item(const Params& p, int item, char* smem) {
  const int tid = get_tid();
  float* sc = (float*)smem;
  const int l = item / 384, rem = item % 384, kc = rem / 24, nc = rem % 24;
  if (tid < 192) {
    int v = tid >> 6, kk = tid & 63, k = kc * 64 + kk;
    float cv = (v == 0) ? p.in[I_CCTX][k] : p.in[I_C][(v - 1) * 1024 + k];
    sc[tid] = silu(cv);
  }
  __syncthreads();
  const int n = nc * 256 + tid;
  const float* W = p.in[I_WADA] + (size_t)l * 1024 * 6144 + (size_t)(kc * 64) * 6144 + n;
  float a0 = 0.f, a1 = 0.f, a2 = 0.f;
#pragma unroll 8
  for (int kk = 0; kk < 64; ++kk) {
    float wv = W[(size_t)kk * 6144];
    a0 += sc[kk] * wv; a1 += sc[64 + kk] * wv; a2 += sc[128 + kk] * wv;
  }
  float* ap = (float*)(p.ws + W_ADAP);
  ap[((kc * 2 + l) * 3 + 0) * 6144 + n] = a0;
  ap[((kc * 2 + l) * 3 + 1) * 6144 + n] = a1;
  ap[((kc * 2 + l) * 3 + 2) * 6144 + n] = a2;
  __syncthreads();
}

DI void phase0(const Params& p, char* smem) {
  for (int it = vbid(); it < 768; it += vgrid()) ada_item(p, it, smem);
}
DI void wprep_all(const Params& p, char* smem) {
  for (int it = vbid(); it < 3048; it += vgrid()) wprep_pair(p, it * 2, smem);
}

DI void phase0b(const Params& p) {
  {
    float* rt = (float*)(p.ws + W_ROPE);
    for (int i = vbid() * 256 + get_tid(); i < 1536; i += vgrid() * 256) {
      int half, pos, fi; float* base;
      if (i < 1024) { half = 16; pos = i >> 4; fi = i & 15; base = rt; }
      else { const int k = i - 1024; half = 8; pos = k >> 3; fi = k & 7; base = rt + 2048; }
      const float fr = exp2f(-(float)fi / (float)half * 13.287712379549449f);
      const float ang = (float)pos * fr;
      base[pos * half + fi] = __cosf(ang);
      base[64 * half + pos * half + fi] = __sinf(ang);
    }
  }
  const float* ap = (const float*)(p.ws + W_ADAP);
  float* am = (float*)(p.ws + W_ADAM);
  float* gb = (float*)(p.ws + W_GB);
  for (int i = vbid() * 256 + get_tid(); i < 2 * 3 * 1024; i += vgrid() * 256) {
    const int l = i / 3072, v = (i % 3072) / 1024, k = i % 1024;
    f32x8 m;
#pragma unroll
    for (int j = 0; j < 6; ++j) {
      float s = p.in[I_BADA][l * 6144 + j * 1024 + k];
      for (int kc = 0; kc < 16; ++kc) s += ap[((kc * 2 + l) * 3 + v) * 6144 + j * 1024 + k];
      m[j] = s;
      am[(l * 3 + v) * 6144 + j * 1024 + k] = s;
    }
    float lg = 1.f, lb = 0.f;
    if (l == 1) { lg = p.in[I_LN2G][k]; lb = p.in[I_LN2B][k]; }
    gb[((l * 2 + 0) * 3 + v) * 2048 + k] = lg * (1.f + m[1]);
    gb[((l * 2 + 0) * 3 + v) * 2048 + 1024 + k] = lb * (1.f + m[1]) + m[0];
    lg = p.in[I_LN1G][l * 1024 + k]; lb = p.in[I_LN1B][l * 1024 + k];
    gb[((l * 2 + 1) * 3 + v) * 2048 + k] = lg * (1.f + m[4]);
    gb[((l * 2 + 1) * 3 + v) * 2048 + 1024 + k] = lb * (1.f + m[4]) + m[3];
  }
}

struct TileWalk {
  int x, j, nb, mtx, total, q;
  DI TileWalk(int MT, int NT) {
    x = blockIdx.x & 7; j = blockIdx.x >> 3; nb = gridDim.x >> 3;
    mtx = (MT - x + 7) >> 3; total = mtx * NT; q = j;
  }
  DI bool next(int& mt, int& nt) {
    if (q >= total) return false;
    mt = (q % mtx) * 8 + x; nt = q / mtx; q += nb;
    return true;
  }
};

DI void p1_epilogue(const Params& p, int l, int m0, int nt, const float* Cs) {
  const int tid = get_tid(), cl = tid & 31, c4 = cl * 4, rr = tid >> 5;
  char* ws = p.ws;
  float* out = p.out;
  const bool den_tile = m0 >= NCTX;
  const bool ropeG = den_tile && nt >= 13 && nt <= 16, ropeM = den_tile && nt == 18;
  float4 ggc = make_float4(1.f, 1.f, 1.f, 1.f);
  if (nt == 12) ggc = *(const float4*)(p.in[I_MKVN] + l * 128 + c4);
  else if (nt >= 13 && nt <= 16) ggc = *(const float4*)(p.in[nt == 16 ? I_GKN : I_GQN] + l * 64 + (c4 & 63));
  const float* rtab = (const float*)(ws + W_ROPE) + (ropeM ? 2048 : 0);
  const int rhalf = ropeM ? 8 : 16;
  const int rd = ropeM ? (c4 & 31) : (c4 & 63);
  const int rblk = ropeM ? (rd >> 4) : (rd >> 5), ri0 = ropeM ? (rd & 7) : (rd & 15);
  float4 rcn = make_float4(1.f, 1.f, 1.f, 1.f), rsn = make_float4(0.f, 0.f, 0.f, 0.f);
  if (ropeG || ropeM) {
    const int s0 = (m0 + rr - NCTX) & 2047;
    const int pos = (rblk == 0) ? (s0 >> 6) : (s0 & 63);
    rcn = *(const float4*)(rtab + pos * rhalf + ri0);
    rsn = *(const float4*)(rtab + 64 * rhalf + pos * rhalf + ri0);
  }
  for (int ps = 0; ps < 16; ++ps) {
    const int r = ps * 8 + rr, t = m0 + r;
    float4 v = *(const float4*)(Cs + r * CS + c4);
    int vv, b, s, kr; tokinfo(t, vv, b, s, kr);
    const bool den = t >= NCTX;
    const float4 rc = rcn, rs = rsn;
    if ((ropeG || ropeM) && ps < 15) {
      const int s1 = (t + 8 - NCTX) & 2047;
      const int pos = (rblk == 0) ? (s1 >> 6) : (s1 & 63);
      rcn = *(const float4*)(rtab + pos * rhalf + ri0);
      rsn = *(const float4*)(rtab + 64 * rhalf + pos * rhalf + ri0);
    }
    if (nt < 10) {
      store_bf4((bf16_t*)(ws + W_ZH) + (size_t)t * 1280 + nt * 128 + c4, v);
    } else if (nt < 12) {
      store_bf4((bf16_t*)(ws + W_MQ) + (size_t)t * 256 + (nt - 10) * 128 + c4, v);
      float ss = v.x * v.x + v.y * v.y + v.z * v.z + v.w * v.w;
      ss += __shfl_xor(ss, 1); ss += __shfl_xor(ss, 2); ss += __shfl_xor(ss, 4); ss += __shfl_xor(ss, 8); ss += __shfl_xor(ss, 16);
      if (cl == 0) ((float*)(ws + W_MQSS))[t * 2 + (nt - 10)] = ss;
    } else if (nt == 12) {
      float ss = v.x * v.x + v.y * v.y + v.z * v.z + v.w * v.w;
      ss += __shfl_xor(ss, 1); ss += __shfl_xor(ss, 2); ss += __shfl_xor(ss, 4); ss += __shfl_xor(ss, 8); ss += __shfl_xor(ss, 16);
      const float sc = rsqrtf(ss * (1.f / 128.f) + EPS);
      const float4 gg = ggc;
      float4 o = make_float4(v.x * sc * gg.x, v.y * sc * gg.y, v.z * sc * gg.z, v.w * sc * gg.w);
      store_bf4((bf16_t*)(ws + W_CKVB) + (size_t)kr * 128 + c4, o);
      if (!den) *(float4*)(out + O_CKV + ((size_t)(b * 2 + l) * 256 + s) * 128 + c4) = o;
    } else if (nt < 17) {
      float ss = v.x * v.x + v.y * v.y + v.z * v.z + v.w * v.w;
      ss += __shfl_xor(ss, 1); ss += __shfl_xor(ss, 2); ss += __shfl_xor(ss, 4); ss += __shfl_xor(ss, 8);
      const float sc = rsqrtf(ss * (1.f / 64.f) + EPS);
      const int d = c4 & 63, hh = c4 >> 6;
      const float4 gg = ggc;
      float4 o = make_float4(v.x * sc * gg.x, v.y * sc * gg.y, v.z * sc * gg.z, v.w * sc * gg.w);
      if (nt == 16 && !den) *(float4*)(out + O_GK + ((size_t)(b * 2 + l) * 256 + s) * 128 + c4) = o;
      float4 po = shfl4(o, 4);
      if (den) o = rope4cs(o, po, (d & 31) < 16, rc, rs);
      if (nt == 16) {
        store_bf4((bf16_t*)(ws + W_KG) + (size_t)kr * 128 + c4, o);
      } else {
        o.x *= GQA_QS; o.y *= GQA_QS; o.z *= GQA_QS; o.w *= GQA_QS;
        store_bf4((bf16_t*)(ws + W_QG) + (size_t)t * 384 + ((nt - 13) * 2 + hh) * 64 + d, o);
      }
    } else if (nt == 17) {
      if (!den) *(float4*)(out + O_GV + ((size_t)(b * 2 + l) * 256 + s) * 128 + c4) = v;
    } else {
      float4 pv = shfl4(v, 2);
      float4 o = v;
      if (den) o = rope4cs(v, pv, (c4 & 15) < 8, rc, rs);
      if (c4 < 32) {
        if (!den) *(float4*)(out + O_KPE + ((size_t)(b * 2 + l) * 256 + s) * 32 + c4) = v;
        bf16_t* km = (bf16_t*)(ws + W_KM) + (size_t)kr * 576 + 64 + c4;
#pragma unroll
        for (int h = 0; h < 6; ++h) store_bf4(km + h * 96, o);
      }
    }
  }
  if (nt == 17) {
    int vv, b, s, kr0; tokinfo(m0, vv, b, s, kr0);
    const int r2 = (tid & 63) * 2;
    bf16_t* vgt = (bf16_t*)(ws + W_VGT);
    for (int i = 0; i < 32; ++i) {
      const int c = (tid >> 6) + 4 * i;
      unsigned pk = pack2(Cs[r2 * CS + c], Cs[(r2 + 1) * CS + c]);
      *(unsigned*)(vgt + (size_t)c * NKR + kr0 + r2) = pk;
    }
  }
}

DI void phase1(const Params& p, int l, char* smem) {
  const bf16_t* WT = (const bf16_t*)(p.ws + W_WIN) + (size_t)l * 2560 * LDX;
  TileWalk512 tw(48, 10);
  int mt, nt2;
  const int hf = get_half();
  while (tw.next(mt, nt2)) {
    const int mbase = mt * 256;
    f32x16 acc[4][2];
    gemm512_main<4>((const bf16_t*)(p.ws + W_MIX) + (size_t)mbase * LDX, LDX, WT + (size_t)nt2 * 256 * LDX, LDX, 1024, smem, acc);
#pragma unroll
    for (int hh = 0; hh < 2; ++hh) {
      gemm512_stage<4>(acc, hh, smem);
      const int nt = nt2 * 2 + hf;
      if (nt < 19) p1_epilogue(p, l, mbase + hh * 128, nt, (const float*)(smem + hf * STG));
      __syncthreads();
    }
  }
  const int gt = vbid() * 256 + get_tid(), gs = vgrid() * 256;
  for (int i = gt; i < 65536; i += gs) {
    const int b = i >> 15, k = (i >> 7) & 255, j = i & 127;
    const int kr = NCTX + b * 2304 + k;
    const size_t src = ((size_t)(b * 2 + l) * 256 + k) * 128 + j;
    ((bf16_t*)(p.ws + W_CKVB))[(size_t)kr * 128 + j] = (bf16_t)f2bf(p.in[I_CCKV][src]);
    ((bf16_t*)(p.ws + W_KG))[(size_t)kr * 128 + j] = (bf16_t)f2bf(p.in[I_CGK][src]);
  }
  for (int i = gt; i < 65536; i += gs) {
    const int b = i >> 15, j = (i >> 8) & 127, k = i & 255;
    const int kr = NCTX + b * 2304 + k;
    ((bf16_t*)(p.ws + W_VGT))[(size_t)j * NKR + kr] = (bf16_t)f2bf(p.in[I_CGV][((size_t)(b * 2 + l) * 256 + k) * 128 + j]);
  }
  for (int i = gt; i < 2 * 256 * 6 * 32; i += gs) {
    const int j = i & 31, h = (i >> 5) % 6, k = (i / 192) & 255, b = i / (192 * 256);
    const int kr = NCTX + b * 2304 + k;
    ((bf16_t*)(p.ws + W_KM))[(size_t)kr * 576 + h * 96 + 64 + j] = (bf16_t)f2bf(p.in[I_CKPE][((size_t)(b * 2 + l) * 256 + k) * 32 + j]);
  }
}

using f32x4v = __attribute__((ext_vector_type(4))) float;
#define MFMA16(a, b, c) __builtin_amdgcn_mfma_f32_16x16x32_bf16((a), (b), (c), 0, 0, 0)
struct HgSmem {
  float sQ[16 * 68], sK[16 * 68], sBC[16 * 68];
  float sO[64 * 64], sCD[64];
  bf16_t sIT[64 * 24];
  bf16_t sKT[64 * 24];
  bf16_t sQB[16 * 72];
  bf16_t sAB[16 * 24];
  bf16_t sST[64 * 72];
};
static_assert(sizeof(HgSmem) <= SMEM_BYTES, "hg smem");
DI bf16_t tobf(float x) { return (bf16_t)(pack2(x, 0.f) & 0xffffu); }

template <bool EMIT>
DI void hgrn_chunk(const Params& p, int l, int tbase, int h, int dir, int c, f32x4v (&S)[4], float& cdtot, HgSmem& sm, bool first_dir) {
  const int tid = get_tid(), lane = tid & 63, w = tid >> 6, n16 = lane & 15, q4 = lane >> 4;
  const bf16_t* zh = (const bf16_t*)(p.ws + W_ZH);
  const int kk = tid & 63, jq = tid >> 6;
  float lb = 0.f;
  if (l == 1) {
    float a0 = p.in[I_HGLB][(0 * 2 + dir) * 256 + h * 64 + kk], a1 = p.in[I_HGLB][(1 * 2 + dir) * 256 + h * 64 + kk];
    lb = fsigmoid(a1 - a0);
  }
  cdtot = 1.f;
  if (EMIT) {
    __syncthreads();
#pragma unroll
    for (int nt = 0; nt < 4; ++nt) {
      uint2 pk; pk.x = pack2(S[nt][0], S[nt][1]); pk.y = pack2(S[nt][2], S[nt][3]);
      *(uint2*)(&sm.sST[(16 * nt + n16) * 72 + 16 * w + 4 * q4]) = pk;
    }
  }
  f32x4 pq, pf, pi;
#define HG_LOAD(scx)                                                                         \
  {                                                                                          \
    _Pragma("unroll") for (int i = 0; i < 4; ++i) {                                          \
      const int j = jq + 4 * i;                                                              \
      const int pos = c * 64 + (scx) * 16 + (dir ? 15 - j : j);                              \
      const bf16_t* zr = zh + (size_t)(tbase + pos) * 1280 + h * 64 + kk;                    \
      pq[i] = bf2f(zr[0]); pf[i] = bf2f(zr[256 * (1 + dir)]); pi[i] = bf2f(zr[768]);         \
    }                                                                                        \
  }
  HG_LOAD(dir ? 3 : 0)
  bf16x8 zero8;
#pragma unroll
  for (int e = 0; e < 8; ++e) zero8[e] = 0;
  for (int scI = 0; scI < 4; ++scI) {
    const int sc = dir ? 3 - scI : scI;
    __syncthreads();
#pragma unroll
    for (int i = 0; i < 4; ++i) {
      const int j = jq + 4 * i;
      const float hq = pq[i], hf = pf[i], hi = pi[i];
      const float e = fexp2(-hf * LOG2E);
      const float sig = frcp(1.f + e);
      const float sign = e * sig;
      const float f = lb + (1.f - lb) * sig;
      sm.sQ[j * 68 + kk] = silu(hq) * 0.125f;
      sm.sK[j * 68 + kk] = (1.f - lb) * sign;
      sm.sBC[j * 68 + kk] = flog2(fmaxf(f, 1e-30f));
      sm.sIT[kk * 24 + j] = tobf(hi);
    }
    if (scI < 3) { const int scn = dir ? 2 - scI : scI + 1; HG_LOAD(scn) }
    __syncthreads();
    if (tid < 64) {
      float run = 0.f;
#pragma unroll
      for (int j = 0; j < 16; ++j) { run += sm.sBC[j * 68 + tid]; sm.sBC[j * 68 + tid] = run; }
      const float cd = fexp2(run);
      sm.sCD[tid] = cd;
      cdtot *= cd;
    }
    __syncthreads();
    if (EMIT) {
      const int j = tid >> 4, s = tid & 15;
      float a = 0.f;
      if (s <= j) {
#pragma unroll 4
        for (int k = 0; k < 64; k += 4) {
          const float4 q4v = *(const float4*)(&sm.sQ[j * 68 + k]), k4 = *(const float4*)(&sm.sK[s * 68 + k]);
          const float4 bj = *(const float4*)(&sm.sBC[j * 68 + k]), bs = *(const float4*)(&sm.sBC[s * 68 + k]);
          a += q4v.x * k4.x * fexp2(bj.x - bs.x) + q4v.y * k4.y * fexp2(bj.y - bs.y)
             + q4v.z * k4.z * fexp2(bj.z - bs.z) + q4v.w * k4.w * fexp2(bj.w - bs.w);
        }
      }
      sm.sAB[(dir ? 15 - j : j) * 24 + s] = tobf(a);
    }
    {
#pragma unroll
      for (int i = 0; i < 4; ++i) {
        const int j = jq + 4 * i;
        const float bc = sm.sBC[j * 68 + kk], bl = sm.sBC[15 * 68 + kk];
        if (EMIT) sm.sQB[(dir ? 15 - j : j) * 72 + kk] = tobf(sm.sQ[j * 68 + kk] * fexp2(bc));
        sm.sKT[kk * 24 + j] = tobf(sm.sK[j * 68 + kk] * fexp2(bl - bc));
      }
    }
    __syncthreads();
    if (EMIT) {
      f32x4v o;
      o[0] = 0.f; o[1] = 0.f; o[2] = 0.f; o[3] = 0.f;
      const bf16x8 bi = *(const bf16x8*)(&sm.sIT[(16 * w + n16) * 24 + 8 * (q4 & 1)]);
      const bf16x8 aa = (q4 < 2) ? *(const bf16x8*)(&sm.sAB[n16 * 24 + 8 * (q4 & 1)]) : zero8;
      o = MFMA16(aa, bi, o);
#pragma unroll
      for (int ks = 0; ks < 2; ++ks) {
        const bf16x8 aq = *(const bf16x8*)(&sm.sQB[n16 * 72 + 32 * ks + 8 * q4]);
        const bf16x8 bs = *(const bf16x8*)(&sm.sST[(16 * w + n16) * 72 + 32 * ks + 8 * q4]);
        o = MFMA16(aq, bs, o);
      }
#pragma unroll
      for (int r = 0; r < 4; ++r) {
        float* op = &sm.sO[(sc * 16 + 4 * q4 + r) * 64 + 16 * w + n16];
        if (first_dir) *op = o[r]; else *op += o[r];
      }
    }
    {
      const f32x4 cd4 = *(const f32x4*)(&sm.sCD[16 * w + 4 * q4]);
      const bf16x8 ak = (q4 < 2) ? *(const bf16x8*)(&sm.sKT[(16 * w + n16) * 24 + 8 * (q4 & 1)]) : zero8;
#pragma unroll
      for (int nt = 0; nt < 4; ++nt) {
        const bf16x8 bi = *(const bf16x8*)(&sm.sIT[(16 * nt + n16) * 24 + 8 * (q4 & 1)]);
        f32x4v cc;
        cc[0] = S[nt][0] * cd4[0]; cc[1] = S[nt][1] * cd4[1]; cc[2] = S[nt][2] * cd4[2]; cc[3] = S[nt][3] * cd4[3];
        S[nt] = MFMA16(ak, bi, cc);
      }
    }
    if (EMIT) {
      __syncthreads();
#pragma unroll
      for (int nt = 0; nt < 4; ++nt) {
        uint2 pk; pk.x = pack2(S[nt][0], S[nt][1]); pk.y = pack2(S[nt][2], S[nt][3]);
        *(uint2*)(&sm.sST[(16 * nt + n16) * 72 + 16 * w + 4 * q4]) = pk;
      }
    }
  }
}

DI int hg_sidx(int seq, int h, int dir, int c) {
  return (seq < 32) ? ((seq * 4 + h) * 2 + dir) * 4 + c : 1024 + (((seq - 32) * 4 + h) * 2 + dir) * 32 + c;
}

DI void hgrn_summary(const Params& p, int l, int item, char* smem) {
  HgSmem& sm = *(HgSmem*)smem;
  const int tid = get_tid();
  int seq, h, dir, c;
  if (item < 1024) { c = item & 3; dir = (item >> 2) & 1; h = (item >> 3) & 3; seq = item >> 5; }
  else { int r = item - 1024; c = r & 31; dir = (r >> 5) & 1; h = (r >> 6) & 3; seq = 32 + (r >> 8); }
  const int tbase = (seq < 32) ? seq * 256 : NCTX + (seq - 32) * 2048;
  f32x4v S[4];
#pragma unroll
  for (int nt = 0; nt < 4; ++nt) { S[nt][0] = 0.f; S[nt][1] = 0.f; S[nt][2] = 0.f; S[nt][3] = 0.f; }
  float cdt;
  hgrn_chunk<false>(p, l, tbase, h, dir, c, S, cdt, sm, true);
  if (tid < 64) ((float*)(p.ws + W_HCD))[(size_t)item * 64 + tid] = cdt;
  float* kv = (float*)(p.ws + W_HKV) + (size_t)item * 4096;
#pragma unroll
  for (int nt = 0; nt < 4; ++nt) *(float4*)(kv + (nt * 256 + tid) * 4) = make_float4(S[nt][0], S[nt][1], S[nt][2], S[nt][3]);
  __syncthreads();
}

DI void hgrn_output(const Params& p, int l, int seq, int h, int c, char* smem) {
  HgSmem& sm = *(HgSmem*)smem;
  const int tid = get_tid(), lane = tid & 63, w = tid >> 6, n16 = lane & 15, q4 = lane >> 4;
  const bool ctx = seq < 32;
  const int NC = ctx ? 4 : 32;
  const int tbase = ctx ? seq * 256 : NCTX + (seq - 32) * 2048;
  const float* hkv = (const float*)(p.ws + W_HKV);
  const float* hcd = (const float*)(p.ws + W_HCD);
  const int k0 = 16 * w + 4 * q4;
  for (int dir = 0; dir < 2; ++dir) {
    f32x4v S[4];
    if (ctx) {
#pragma unroll
      for (int nt = 0; nt < 4; ++nt) { S[nt][0] = 0.f; S[nt][1] = 0.f; S[nt][2] = 0.f; S[nt][3] = 0.f; }
    } else {
      const float* s0 = p.in[I_SHG] + ((((size_t)(seq - 32) * 2 + l) * 2 + dir) * 4 + h) * 4096;
#pragma unroll
      for (int nt = 0; nt < 4; ++nt)
#pragma unroll
        for (int r = 0; r < 4; ++r) S[nt][r] = s0[(k0 + r) * 64 + 16 * nt + n16];
    }
    const int nprev = dir ? NC - 1 - c : c;
#pragma unroll 4
    for (int q = 0; q < nprev; ++q) {
      const int m = dir ? NC - 1 - q : q;
      const int si = hg_sidx(seq, h, dir, m);
      const float4 cd = *(const float4*)(hcd + (size_t)si * 64 + k0);
      const float* kv = hkv + (size_t)si * 4096;
#pragma unroll
      for (int nt = 0; nt < 4; ++nt) {
        const float4 t = *(const float4*)(kv + (nt * 256 + tid) * 4);
        S[nt][0] = S[nt][0] * cd.x + t.x; S[nt][1] = S[nt][1] * cd.y + t.y;
        S[nt][2] = S[nt][2] * cd.z + t.z; S[nt][3] = S[nt][3] * cd.w + t.w;
      }
    }
    float cdt;
    hgrn_chunk<true>(p, l, tbase, h, dir, c, S, cdt, sm, dir == 0);
    if (ctx && ((dir == 0 && c == NC - 1) || (dir == 1 && c == 0))) {
      float* so = p.out + O_HG + ((((size_t)seq * 2 + l) * 2 + dir) * 4 + h) * 4096;
#pragma unroll
      for (int nt = 0; nt < 4; ++nt)
#pragma unroll
        for (int r = 0; r < 4; ++r) so[(k0 + r) * 64 + 16 * nt + n16] = S[nt][r];
    }
  }
  __syncthreads();
  {
    const int pos = tid >> 2, part = tid & 3;
    const int t = tbase + c * 64 + pos;
    f32x16 o;
    float ss = 0.f;
#pragma unroll
    for (int i = 0; i < 16; ++i) { o[i] = sm.sO[pos * 64 + part * 16 + i]; ss += o[i] * o[i]; }
    ss += __shfl_xor(ss, 1); ss += __shfl_xor(ss, 2);
    const float sc = rsqrtf(ss * (1.f / 64.f) + EPS);
    const bf16_t* zg = (const bf16_t*)(p.ws + W_ZH) + (size_t)t * 1280 + 1024 + h * 64 + part * 16;
    const float* ng = p.in[I_HGN] + l * 64 + part * 16;
    bf16_t* mx = (bf16_t*)(p.ws + W_MIX) + (size_t)t * LDX + h * 64 + part * 16;
#pragma unroll
    for (int i4 = 0; i4 < 4; ++i4) {
      float4 r;
      r.x = o[i4 * 4 + 0] * sc * ng[i4 * 4 + 0] * silu(bf2f(zg[i4 * 4 + 0]));
      r.y = o[i4 * 4 + 1] * sc * ng[i4 * 4 + 1] * silu(bf2f(zg[i4 * 4 + 1]));
      r.z = o[i4 * 4 + 2] * sc * ng[i4 * 4 + 2] * silu(bf2f(zg[i4 * 4 + 2]));
      r.w = o[i4 * 4 + 3] * sc * ng[i4 * 4 + 3] * silu(bf2f(zg[i4 * 4 + 3]));
      store_bf4(mx + i4 * 4, r);
    }
  }
  __syncthreads();
}

DI void attn_dispatch(const Params& p, int type, int t0, int kr0, int nkeys, int h, char* smem);
DI void phase2(const Params& p, int l, char* smem) {
  char* ws = p.ws;
  __shared__ int s_pair2;
  unsigned* ctr = (unsigned*)(p.ws + W_BAR) + 3456 + (4 + l) * 16;
  const int half = get_half();
  for (;;) {
    __syncthreads();
    if (get_tid512() == 0) s_pair2 = (int)__hip_atomic_fetch_add(ctr, 1u, __ATOMIC_RELAXED, __HIP_MEMORY_SCOPE_AGENT);
    __syncthreads();
    const int pair = s_pair2;
    if (pair >= 1644) break;
    const int qi = pair * 2 + half;
    if (qi < 192) {
      const int b = qi / 96, h = (qi % 96) / 16, qb = qi % 16;
      attn_dispatch(p, 1, NCTX + b * 2048 + qb * 128, NCTX + b * 2304, 2304, h, smem);
      continue;
    }
    if (qi >= 2904) {
      const int i = qi - 2904;
      const int b = i / 12, h = (i % 12) / 2, qb = i % 2;
      attn_dispatch(p, 1, b * 256 + qb * 128, b * 256, 256, h, smem);
      continue;
    }
    const int it = (qi < 1728) ? 1176 + (qi - 192) : qi - 1728;
    if (it < 576) {
      const int mt = it / 6, h = it % 6, m0 = mt * 128;
      gemm_core((const bf16_t*)(ws + W_MQ) + (size_t)m0 * 256, 256,
                (const bf16_t*)(ws + W_WUQ) + ((size_t)l * 768 + h * 128) * 256, 256, 256, smem);
      const float* Cs = (const float*)smem;
      const int tid = get_tid(), cl = tid & 31, c4 = cl * 4, rr = tid >> 5;
      const float* mqss = (const float*)(ws + W_MQSS);
      for (int ps = 0; ps < 16; ++ps) {
        const int r = ps * 8 + rr, t = m0 + r;
        float4 v = *(const float4*)(Cs + r * CS + c4);
        const float sc = rsqrtf((mqss[t * 2] + mqss[t * 2 + 1]) * (1.f / 256.f) + EPS) * MLA_QS;
        v.x *= sc; v.y *= sc; v.z *= sc; v.w *= sc;
        float4 pv = shfl4(v, 2);
        if (t >= NCTX && c4 >= 64) {
          const int s = (t - NCTX) & 2047;
          const int d = c4 - 64, blk = (d >> 4) & 1, pd = d & 15;
          const int pos = (blk == 0) ? (s >> 6) : (s & 63);
          v = rope4(v, pv, pd & 7, pd < 8, pos, (const float*)(ws + W_ROPE) + 2048, 8);
        }
        if (c4 < 96) store_bf4((bf16_t*)(ws + W_QM) + (size_t)t * 576 + h * 96 + c4, v);
      }
      __syncthreads();
    } else if (it < 1176) {
      const int i2 = it - 576;
      const int mt = i2 / 6, h = i2 % 6, m0 = mt * 128;
      gemm_core((const bf16_t*)(ws + W_CKVB) + (size_t)m0 * 128, 128,
                (const bf16_t*)(ws + W_WUKV) + ((size_t)l * 768 + h * 128) * 128, 128, 128, smem);
      const float* Cs = (const float*)smem;
      const int tid = get_tid();
      {
        const int c8 = (tid & 7) * 8, rr = tid >> 3;
        for (int ps = 0; ps < 4; ++ps) {
          const int r = ps * 32 + rr;
          const float4 v0 = *(const float4*)(Cs + r * CS + c8), v1 = *(const float4*)(Cs + r * CS + c8 + 4);
          u32x4 pk; pk[0] = pack2(v0.x, v0.y); pk[1] = pack2(v0.z, v0.w); pk[2] = pack2(v1.x, v1.y); pk[3] = pack2(v1.z, v1.w);
          *(u32x4*)((bf16_t*)(ws + W_KM) + (size_t)(m0 + r) * 576 + h * 96 + c8) = pk;
        }
      }
      {
        bf16_t* vmt = (bf16_t*)(ws + W_VMT);
#pragma unroll 2
        for (int i = 0; i < 4; ++i) {
          const int idx = tid + 256 * i, rg = idx & 15, dv = idx >> 4;
          const float* cp = Cs + (rg * 8) * CS + 64 + dv;
          u32x4 pk;
          pk[0] = pack2(cp[0], cp[CS]); pk[1] = pack2(cp[2 * CS], cp[3 * CS]);
          pk[2] = pack2(cp[4 * CS], cp[5 * CS]); pk[3] = pack2(cp[6 * CS], cp[7 * CS]);
          *(u32x4*)(vmt + (size_t)(h * 64 + dv) * NKR + m0 + rg * 8) = pk;
        }
      }
      __syncthreads();
    } else {
      hgrn_summary(p, l, it - 1176, smem);
    }
  }
}

template <int DK>
DI void attn_item(const bf16_t* __restrict__ Qp, int qstride, const bf16_t* __restrict__ Kp, int kstride,
                  const bf16_t* __restrict__ Vtp, int nkeys, bf16_t* __restrict__ outp, char* smem) {
  constexpr int KSTR = (DK + 8) * 2;
  constexpr int KCH = DK / 8;
  constexpr int NKC = 64 * KCH / 256;
  const int tid = get_tid(), lane = tid & 63, w = tid >> 6, l32 = lane & 31, g = lane >> 5;
  char* Ks = smem;
  char* Vs = smem + 64 * KSTR;
  bf16x8 qf[DK / 16];
#pragma unroll
  for (int ks = 0; ks < DK / 16; ++ks) qf[ks] = *(const bf16x8*)(Qp + (size_t)(w * 32 + l32) * qstride + ks * 16 + g * 8);
  f32x16 O0, O1;
#pragma unroll
  for (int e = 0; e < 16; ++e) { O0[e] = 0.f; O1[e] = 0.f; }
  float m_run = -1e30f, l_part = 0.f;
  u32x16 rkA, rkB;
  u32x8 rvA, rvB;
  const int nkt = nkeys >> 6;
  constexpr int ABUF = 64 * KSTR + 64 * 144;
#define ATT_LOAD(RK, RV, key0)                                                                                     \
  {                                                                                                                \
    _Pragma("unroll") for (int i = 0; i < NKC; ++i) {                                                              \
      const int idx = tid + 256 * i, row = idx / KCH, ch = idx % KCH;                                              \
      const u32x4 t = *(const u32x4*)(Kp + (size_t)((key0) + row) * kstride + ch * 8);                             \
      RK[i * 4] = t[0]; RK[i * 4 + 1] = t[1]; RK[i * 4 + 2] = t[2]; RK[i * 4 + 3] = t[3];                          \
    }                                                                                                              \
    _Pragma("unroll") for (int i = 0; i < 2; ++i) {                                                                \
      const int idx = tid + 256 * i, row = idx >> 3, ch = idx & 7;                                                 \
      const u32x4 t = *(const u32x4*)(Vtp + (size_t)row * NKR + (key0) + ch * 8);                                  \
      RV[i * 4] = t[0]; RV[i * 4 + 1] = t[1]; RV[i * 4 + 2] = t[2]; RV[i * 4 + 3] = t[3];                          \
    }                                                                                                              \
  }
#define ATT_PUT(RK, RV, buf)                                                                                       \
  {                                                                                                                \
    _Pragma("unroll") for (int i = 0; i < NKC; ++i) {                                                              \
      const int idx = tid + 256 * i, row = idx / KCH, ch = idx % KCH;                                              \
      u32x4 t; t[0] = RK[i * 4]; t[1] = RK[i * 4 + 1]; t[2] = RK[i * 4 + 2]; t[3] = RK[i * 4 + 3];                 \
      *(u32x4*)(Ks + (buf) * ABUF + row * KSTR + ch * 16) = t;                                                     \
    }                                                                                                              \
    _Pragma("unroll") for (int i = 0; i < 2; ++i) {                                                                \
      const int idx = tid + 256 * i, row = idx >> 3, ch = idx & 7;                                                 \
      u32x4 t; t[0] = RV[i * 4]; t[1] = RV[i * 4 + 1]; t[2] = RV[i * 4 + 2]; t[3] = RV[i * 4 + 3];                 \
      *(u32x4*)(Vs + (buf) * ABUF + row * 144 + ch * 16) = t;                                                      \
    }                                                                                                              \
  }
  auto compute = [&](const char* Kc, const char* Vc) {
    f32x16 s0, s1;
#pragma unroll
    for (int e = 0; e < 16; ++e) { s0[e] = 0.f; s1[e] = 0.f; }
#pragma unroll
    for (int ks = 0; ks < DK / 16; ++ks) {
      bf16x8 a0 = *(const bf16x8*)(Kc + l32 * KSTR + (ks * 16 + g * 8) * 2);
      bf16x8 a1 = *(const bf16x8*)(Kc + (32 + l32) * KSTR + (ks * 16 + g * 8) * 2);
      s0 = MFMA(a0, qf[ks], s0);
      s1 = MFMA(a1, qf[ks], s1);
    }
    float mx = s0[0];
#pragma unroll
    for (int e = 0; e < 16; ++e) { mx = fmaxf(mx, s0[e]); mx = fmaxf(mx, s1[e]); }
    mx = fmaxf(mx, __shfl_xor(mx, 32));
    const float mnew = fmaxf(m_run, mx);
    const float alpha = fexp2(m_run - mnew);
    m_run = mnew;
    float ps = 0.f;
#pragma unroll
    for (int e = 0; e < 16; ++e) { s0[e] = fexp2(s0[e] - mnew); s1[e] = fexp2(s1[e] - mnew); ps += s0[e] + s1[e]; }
    l_part = l_part * alpha + ps;
#pragma unroll
    for (int e = 0; e < 16; ++e) { O0[e] *= alpha; O1[e] *= alpha; }
#pragma unroll
    for (int mt = 0; mt < 2; ++mt) {
#pragma unroll
      for (int hh = 0; hh < 2; ++hh) {
        u32x4 pfu;
#pragma unroll
        for (int e = 0; e < 4; ++e) {
          const float x0 = mt ? s1[hh * 8 + 2 * e] : s0[hh * 8 + 2 * e];
          const float x1 = mt ? s1[hh * 8 + 2 * e + 1] : s0[hh * 8 + 2 * e + 1];
          pfu[e] = pack2(x0, x1);
        }
        const bf16x8 pf = __builtin_bit_cast(bf16x8, pfu);
        const int kb = (mt * 32 + hh * 16 + 4 * g) * 2;
        const u32x2 va = *(const u32x2*)(Vc + l32 * 144 + kb), vb = *(const u32x2*)(Vc + l32 * 144 + kb + 16);
        const u32x2 vc = *(const u32x2*)(Vc + (32 + l32) * 144 + kb), vd = *(const u32x2*)(Vc + (32 + l32) * 144 + kb + 16);
        u32x4 v0u, v1u;
        v0u[0] = va[0]; v0u[1] = va[1]; v0u[2] = vb[0]; v0u[3] = vb[1];
        v1u[0] = vc[0]; v1u[1] = vc[1]; v1u[2] = vd[0]; v1u[3] = vd[1];
        O0 = MFMA(__builtin_bit_cast(bf16x8, v0u), pf, O0);
        O1 = MFMA(__builtin_bit_cast(bf16x8, v1u), pf, O1);
      }
    }
  };
  ATT_LOAD(rkA, rvA, 0)
  ATT_PUT(rkA, rvA, 0)
  ATT_LOAD(rkA, rvA, 64)
  if (nkt > 2) ATT_LOAD(rkB, rvB, 128)
  __syncthreads();
  for (int kt = 0; kt < nkt; kt += 2) {
    __builtin_amdgcn_sched_barrier(0);
    compute(Ks, Vs);
    __builtin_amdgcn_sched_barrier(0);
    ATT_PUT(rkA, rvA, 1)
    if (kt + 3 < nkt) { const int k3 = (kt + 3) << 6; ATT_LOAD(rkA, rvA, k3) }
    __syncthreads();
    __builtin_amdgcn_sched_barrier(0);
    compute(Ks + ABUF, Vs + ABUF);
    __builtin_amdgcn_sched_barrier(0);
    if (kt + 2 < nkt) ATT_PUT(rkB, rvB, 0)
    if (kt + 4 < nkt) { const int k4 = (kt + 4) << 6; ATT_LOAD(rkB, rvB, k4) }
    __syncthreads();
  }
  const float lt = l_part + __shfl_xor(l_part, 32);
  const float inv = 1.f / lt;
  bf16_t* orow = outp + (size_t)(w * 32 + l32) * LDX;
#pragma unroll
  for (int j4 = 0; j4 < 4; ++j4) {
    store_bf4(orow + 8 * j4 + 4 * g, make_float4(O0[j4 * 4] * inv, O0[j4 * 4 + 1] * inv, O0[j4 * 4 + 2] * inv, O0[j4 * 4 + 3] * inv));
    store_bf4(orow + 32 + 8 * j4 + 4 * g, make_float4(O1[j4 * 4] * inv, O1[j4 * 4 + 1] * inv, O1[j4 * 4 + 2] * inv, O1[j4 * 4 + 3] * inv));
  }
}

DI void attn_dispatch(const Params& p, int type, int t0, int kr0, int nkeys, int h, char* smem) {
  char* ws = p.ws;
  bf16_t* mix = (bf16_t*)(ws + W_MIX) + (size_t)t0 * LDX;
  if (type == 0) {
    attn_item<96>((const bf16_t*)(ws + W_QM) + (size_t)t0 * 576 + h * 96, 576, (const bf16_t*)(ws + W_KM) + (size_t)kr0 * 576 + h * 96, 576,
                  (const bf16_t*)(ws + W_VMT) + (size_t)(h * 64) * NKR + kr0, nkeys, mix + 256 + h * 64, smem);
  } else {
    const int kvh = h / 3;
    attn_item<64>((const bf16_t*)(ws + W_QG) + (size_t)t0 * 384 + h * 64, 384, (const bf16_t*)(ws + W_KG) + (size_t)kr0 * 128 + kvh * 64, 128,
                  (const bf16_t*)(ws + W_VGT) + (size_t)(kvh * 64) * NKR + kr0, nkeys, mix + 640 + h * 64, smem);
  }
}

DI void phase3(const Params& p, int l, char* smem) {
  __shared__ int s_pair;
  unsigned* ctr = (unsigned*)(p.ws + W_BAR) + 3456 + l * 16;
  const int half = get_half();
  for (;;) {
    __syncthreads();
    if (get_tid512() == 0) s_pair = (int)__hip_atomic_fetch_add(ctr, 1u, __ATOMIC_RELAXED, __HIP_MEMORY_SCOPE_AGENT);
    __syncthreads();
    const int pair = s_pair;
    if (pair >= 672) break;
    const int qi = pair * 2 + half;
    if (qi < 256) {
      hgrn_output(p, l, 32 + qi / 128, (qi % 128) / 32, qi % 32, smem);
    } else if (qi < 448) {
      const int r = qi - 256, b = r / 96, h = (r % 96) / 16, qb = r % 16;
      attn_dispatch(p, 0, NCTX + b * 2048 + qb * 128, NCTX + b * 2304, 2304, h, smem);
    } else if (qi < 960) {
      const int i = qi - 448;
      hgrn_output(p, l, i / 16, (i % 16) / 4, i % 4, smem);
    } else {
      const int r = qi - 960, b = r / 12, h = (r % 12) / 2, qb = r % 2;
      attn_dispatch(p, 0, b * 256 + qb * 128, b * 256, 256, h, smem);
    }
  }
}

template <int WHICH>
DI void phase46(const Params& p, int l, char* smem) {
  char* ws = p.ws;
  const float* am = (const float*)(ws + W_ADAM);
  TileWalk512 tw(64, 4);
  int mt, nt2;
  const int hf = get_half();
  while (tw.next(mt, nt2)) {
    const int mbase = mt * 192, n0 = nt2 * 256 + hf * 128;
    f32x16 acc[3][2];
    if (WHICH == 4)
      gemm512_main<3>((const bf16_t*)(ws + W_MIX) + (size_t)mbase * LDX, LDX,
                   (const bf16_t*)(ws + W_WOUT) + ((size_t)l * 1024 + nt2 * 256) * LDX, LDX, 1024, smem, acc);
    else
      gemm512_main<3>((const bf16_t*)(ws + W_HID) + (size_t)mbase * LDH, LDH,
                   (const bf16_t*)(ws + W_WFO) + ((size_t)l * 1024 + nt2 * 256) * LDH, LDH, 2816, smem, acc);
#pragma unroll
    for (int hh = 0; hh < 2; ++hh) {
    const int m0 = mbase + hh * 96;
    gemm512_stage<3>(acc, hh, smem);
    const int va = (m0 < NCTX) ? 0 : 1 + ((m0 - NCTX) >> 11), vb2 = (m0 + 95 < NCTX) ? 0 : 1 + ((m0 + 95 - NCTX) >> 11);
    const float* Cs = (const float*)(smem + hf * STG);
    const int tid = get_tid(), cl = tid & 31, c4 = cl * 4, rr = tid >> 5;
    const int c = n0 + c4;
    const float4 gateA = *(const float4*)(am + (l * 3 + va) * 6144 + (WHICH == 4 ? 2048 : 5120) + c);
    const float4 gateB = *(const float4*)(am + (l * 3 + vb2) * 6144 + (WHICH == 4 ? 2048 : 5120) + c);
    float4 lg = make_float4(1.f, 1.f, 1.f, 1.f), lb = make_float4(0.f, 0.f, 0.f, 0.f);
    bool ln = true;
    if (WHICH == 4) {
      if (l == 0) ln = false;
      else { lg = *(const float4*)(p.in[I_LN2G] + c); lb = *(const float4*)(p.in[I_LN2B] + c); }
    } else {
      lg = *(const float4*)(p.in[I_LN1G] + l * 1024 + c); lb = *(const float4*)(p.in[I_LN1B] + l * 1024 + c);
    }
    const float* st = (const float*)(ws + (WHICH == 4 ? W_STB : W_STA));
    for (int pb = 0; pb < 12; pb += 2) {
      f32x8 xr;
      f32x4 sr;
#pragma unroll
      for (int u = 0; u < 2; ++u) {
        const int t = m0 + (pb + u) * 8 + rr;
        const float* xp;
        if (WHICH == 4 && l == 0) xp = ((t < NCTX) ? p.in[I_XP] + (size_t)t * 1024 : p.in[I_XS] + (size_t)(t - NCTX) * 1024) + c;
        else xp = p.out + (size_t)t * 1024 + c;
        const f32x4 t4 = *(const f32x4*)xp;
        xr[u * 4] = t4[0]; xr[u * 4 + 1] = t4[1]; xr[u * 4 + 2] = t4[2]; xr[u * 4 + 3] = t4[3];
        if (ln) { sr[u * 2] = ld_dev(st + t * 32); sr[u * 2 + 1] = ld_dev(st + t * 32 + 1); }
        else { sr[u * 2] = 0.f; sr[u * 2 + 1] = 1.f; }
      }
#pragma unroll
      for (int u = 0; u < 2; ++u) {
        const int r = (pb + u) * 8 + rr, t = m0 + r;
        const float4 y = *(const float4*)(Cs + r * CS + c4);
        float4 x = make_float4(xr[u * 4], xr[u * 4 + 1], xr[u * 4 + 2], xr[u * 4 + 3]);
        if (ln) {
          const float mean = sr[u * 2], rstd = sr[u * 2 + 1];
          x.x = (x.x - mean) * rstd * lg.x + lb.x; x.y = (x.y - mean) * rstd * lg.y + lb.y;
          x.z = (x.z - mean) * rstd * lg.z + lb.z; x.w = (x.w - mean) * rstd * lg.w + lb.w;
        }
        const int vrow = (t < NCTX) ? 0 : 1 + ((t - NCTX) >> 11);
        const float4 gate = (vrow == va) ? gateA : gateB;
        float4 o;
        o.x = ALPHA * x.x + gate.x * y.x; o.y = ALPHA * x.y + gate.y * y.y;
        o.z = ALPHA * x.z + gate.z * y.z; o.w = ALPHA * x.w + gate.w * y.w;
        *(float4*)(p.out + (size_t)t * 1024 + c) = o;
      }
    }
    __syncthreads();
    }
  }
}

DI void phase_rowprep(const Params& p, int l, int which) {
  const int lane = get_tid() & 63;
  const int gw = vbid() * 4 + (get_tid() >> 6), nw = vgrid() * 4;
  const bool ln = !(which == 0 && l == 0);
  float* st = (float*)(p.ws + (which == 0 ? W_STB : W_STA));
  bf16_t* hb = (bf16_t*)(p.ws + W_MIX);
  for (int t = gw; t < NTOK; t += nw) {
    const int v = (t < NCTX) ? 0 : 1 + ((t - NCTX) >> 11);
    const float* row;
    if (!ln) row = (t < NCTX) ? p.in[I_XP] + (size_t)t * 1024 : p.in[I_XS] + (size_t)(t - NCTX) * 1024;
    else row = p.out + (size_t)t * 1024;
    const float* gb = (const float*)(p.ws + W_GB) + ((l * 2 + which) * 3 + v) * 2048;
    f32x16 x;
    float s = 0.f;
#pragma unroll
    for (int i = 0; i < 4; ++i) {
      const f32x4 t4 = *(const f32x4*)(row + i * 256 + lane * 4);
      x[i * 4] = t4[0]; x[i * 4 + 1] = t4[1]; x[i * 4 + 2] = t4[2]; x[i * 4 + 3] = t4[3];
      s += t4[0] + t4[1] + t4[2] + t4[3];
    }
    float rstd = 1.f;
    if (ln) {
#pragma unroll
      for (int m = 1; m < 64; m <<= 1) s += __shfl_xor(s, m);
      const float mean = s * (1.f / 1024.f);
      float s2 = 0.f;
#pragma unroll
      for (int i = 0; i < 16; ++i) { x[i] -= mean; s2 += x[i] * x[i]; }
#pragma unroll
      for (int m = 1; m < 64; m <<= 1) s2 += __shfl_xor(s2, m);
      rstd = rsqrtf(s2 * (1.f / 1024.f) + EPS);
      if (lane == 0) { st[t * 32] = mean; st[t * 32 + 1] = rstd; }
    }
#pragma unroll
    for (int i = 0; i < 4; ++i) {
      const float4 gg = *(const float4*)(gb + i * 256 + lane * 4), bb = *(const float4*)(gb + 1024 + i * 256 + lane * 4);
      store_bf4(hb + (size_t)t * LDX + i * 256 + lane * 4,
                make_float4(x[i * 4] * rstd * gg.x + bb.x, x[i * 4 + 1] * rstd * gg.y + bb.y, x[i * 4 + 2] * rstd * gg.z + bb.z, x[i * 4 + 3] * rstd * gg.w + bb.w));
    }
  }
}

DI void phase5(const Params& p, int l, char* smem) {
  char* ws = p.ws;
  const int hf = get_half();
  auto epilogue = [&](int m0, int nt, const float* Cs, int npass) {
    const int tid = get_tid(), q = (tid & 15) * 4, rr = tid >> 4;
    const int grp = q >> 5, jj = q & 31;
    bf16_t* hid = (bf16_t*)(ws + W_HID);
    for (int ps = 0; ps < npass; ++ps) {
      const int r = ps * 16 + rr, t = m0 + r;
      const float4 gt = *(const float4*)(Cs + r * CS + grp * 64 + jj);
      const float4 up = *(const float4*)(Cs + r * CS + grp * 64 + 32 + jj);
      float4 o = make_float4(silu(gt.x) * up.x, silu(gt.y) * up.y, silu(gt.z) * up.z, silu(gt.w) * up.w);
      store_bf4(hid + (size_t)t * LDH + nt * 64 + q, o);
    }
  };
  const int x = blockIdx.x & 7, j = blockIdx.x >> 3, nb = gridDim.x >> 3;
  const int mtx = (48 - x + 7) >> 3, total = mtx * 22;
  const int full = (total / nb) * nb;
  for (int q = j; q < full; q += nb) {
    const int mt = (q % mtx) * 8 + x, nt2 = q / mtx;
    const int mbase = mt * 256;
    const int nt = nt2 * 2 + hf;
    f32x16 acc[4][2];
    gemm512_main<4>((const bf16_t*)(ws + W_MIX) + (size_t)mbase * LDX, LDX,
                    (const bf16_t*)(ws + W_WFI) + ((size_t)l * 5632 + nt2 * 256) * LDX, LDX, 1024, smem, acc);
#pragma unroll
    for (int hh = 0; hh < 2; ++hh) {
      gemm512_stage<4>(acc, hh, smem);
      epilogue(mbase + hh * 128, nt, (const float*)(smem + hf * STG), 8);
      __syncthreads();
    }
  }
  for (int jq = j; jq < 4 * (total - full); jq += nb) {
    const int q = full + (jq >> 2);
    const int mt = (q % mtx) * 8 + x, nt2 = q / mtx;
    const int mbase = mt * 256 + (jq & 3) * 64;
    const int nt = nt2 * 2 + hf;
    f32x16 acc[1][2];
    gemm512_main<1>((const bf16_t*)(ws + W_MIX) + (size_t)mbase * LDX, LDX,
                    (const bf16_t*)(ws + W_WFI) + ((size_t)l * 5632 + nt2 * 256) * LDX, LDX, 1024, smem, acc);
#pragma unroll
    for (int hh = 0; hh < 2; ++hh) {
      gemm512_stage<1>(acc, hh, smem);
      epilogue(mbase + hh * 32, nt, (const float*)(smem + hf * STG), 2);
      __syncthreads();
    }
  }
}

DI void phase7(const Params& p) {
  const int lane = get_tid() & 63;
  const int gw = vbid() * 4 + (get_tid() >> 6), nw = vgrid() * 4;
  const float* g = p.in[I_LN2G] + 1024;
  const float* b = p.in[I_LN2B] + 1024;
  for (int t = gw; t < NTOK; t += nw) {
    float* row = p.out + (size_t)t * 1024;
    f32x16 x;
    float s = 0.f;
#pragma unroll
    for (int i = 0; i < 4; ++i) {
      const f32x4 t4 = *(const f32x4*)(row + i * 256 + lane * 4);
      x[i * 4] = t4[0]; x[i * 4 + 1] = t4[1]; x[i * 4 + 2] = t4[2]; x[i * 4 + 3] = t4[3];
      s += t4[0] + t4[1] + t4[2] + t4[3];
    }
#pragma unroll
    for (int m = 1; m < 64; m <<= 1) s += __shfl_xor(s, m);
    const float mean = s * (1.f / 1024.f);
    float s2 = 0.f;
#pragma unroll
    for (int i = 0; i < 16; ++i) { x[i] -= mean; s2 += x[i] * x[i]; }
#pragma unroll
    for (int m = 1; m < 64; m <<= 1) s2 += __shfl_xor(s2, m);
    const float rstd = rsqrtf(s2 * (1.f / 1024.f) + EPS);
#pragma unroll
    for (int i = 0; i < 4; ++i) {
      const float4 gg = *(const float4*)(g + i * 256 + lane * 4), bb = *(const float4*)(b + i * 256 + lane * 4);
      float4 o = make_float4(x[i * 4] * rstd * gg.x + bb.x, x[i * 4 + 1] * rstd * gg.y + bb.y, x[i * 4 + 2] * rstd * gg.z + bb.z, x[i * 4 + 3] * rstd * gg.w + bb.w);
      *(float4*)(row + i * 256 + lane * 4) = o;
    }
  }
}

constexpr int NPHASE = 19;
DI void run_phase(const Params& p, int ph, char* smem) {
  char* smh = smem + get_half() * STG;
  if (ph == 0) phase0(p, smh);
  else if (ph == 1) phase0b(p);
  else if (ph == NPHASE - 1) phase7(p);
  else {
    const int l = (ph - 2) >> 3, s = (ph - 2) & 7;
    if (s == 0) { if (l == 0) wprep_all(p, smh); phase_rowprep(p, l, 0); }
    else if (s == 1) phase1(p, l, smem);
    else if (s == 2) phase2(p, l, smh);
    else if (s == 3) phase3(p, l, smh);
    else if (s == 4) phase46<4>(p, l, smem);
    else if (s == 5) phase_rowprep(p, l, 1);
    else if (s == 6) phase5(p, l, smem);
    else phase46<6>(p, l, smem);
  }
}

#define XB_TMO      128
#define XB_XCNT(j)  (256  + 64 * (j))
#define XB_XSUB(j)  (1280 + 64 * (j))
#define XB_XGEN(j)  (2304 + 64 * (j))
#define XB_TOP      3328
#define XB_TOPGEN   3392
#define XCD_BAR_WORDS 3456
#define XB_SPIN_CAP (1u << 22)
#define LAS __attribute__((address_space(3)))
DI unsigned xb_ld(unsigned* p) { return __hip_atomic_load(p, __ATOMIC_RELAXED, __HIP_MEMORY_SCOPE_AGENT); }
DI unsigned xb_add(unsigned* p, unsigned v) { return __hip_atomic_fetch_add(p, v, __ATOMIC_RELAXED, __HIP_MEMORY_SCOPE_AGENT); }
DI unsigned xb_xcc_id() { return (unsigned)__builtin_amdgcn_s_getreg((3 << 11) | 20) & 0xFu; }
#define XB_SPIN(cond, bar) do { unsigned _sp = 0; while (cond) { __builtin_amdgcn_s_sleep(1); \
    if ((++_sp & 255u) == 0u) { if (xb_ld(&(bar)[XB_TMO])) break; if (_sp > XB_SPIN_CAP) { atomicAdd(&(bar)[XB_TMO], 1u); break; } } } } while (0)
struct XcdBarrier { unsigned* bar; unsigned x; volatile LAS unsigned* st; };
DI XcdBarrier xcd_barrier_post(unsigned* bar, volatile LAS unsigned* st) {
  XcdBarrier b; b.bar = bar; b.x = xb_xcc_id(); b.st = st;
  if (__builtin_amdgcn_workitem_id_x() == 0) (void)xb_add(&bar[XB_XCNT(b.x)], 1u);
  return b;
}
DI void xcd_barrier_complete(unsigned* bar, unsigned x, unsigned& nloc, unsigned& nx) {
  const unsigned G = gridDim.x * gridDim.y * gridDim.z;
  unsigned sum, cnt, mine, sp = 0u;
  for (;;) {
    sum = 0u; cnt = 0u; mine = 0u;
#pragma unroll
    for (unsigned j = 0; j < 16; ++j) { const unsigned c = xb_ld(&bar[XB_XCNT(j)]); sum += c; cnt += (c > 0u) ? 1u : 0u; mine = (j == x) ? c : mine; }
    if (sum == G) break;
    __builtin_amdgcn_s_sleep(1);
    if ((++sp & 255u) == 0u) { if (xb_ld(&bar[XB_TMO])) break; if (sp > XB_SPIN_CAP) { atomicAdd(&bar[XB_TMO], 1u); break; } }
  }
  nloc = mine > 0u ? mine : 1u; nx = cnt > 0u ? cnt : 1u;
}
DI void xcd_barrier(const XcdBarrier& b) {
  asm volatile("s_waitcnt vmcnt(0)" ::: "memory");
  __syncthreads();
  if (__builtin_amdgcn_workitem_id_x() == 0) {
    unsigned* bar = b.bar;
    __builtin_amdgcn_s_waitcnt(0);
    unsigned nloc = b.st[0], nx = b.st[1];
    if (nloc == 0u) { xcd_barrier_complete(bar, b.x, nloc, nx); b.st[0] = nloc; b.st[1] = nx; }
    const unsigned old = xb_add(&bar[XB_XSUB(b.x)], 1u);
    const unsigned gen = old / nloc;
    if (old + 1u == (gen + 1u) * nloc) {
      __builtin_amdgcn_fence(__ATOMIC_RELEASE, "agent");
      asm volatile("s_waitcnt vmcnt(0)" ::: "memory");
      const unsigned og = xb_add(&bar[XB_TOP], 1u);
      const unsigned tg = og / nx;
      if (og + 1u == (tg + 1u) * nx) xb_add(&bar[XB_TOPGEN], 1u);
      else XB_SPIN(xb_ld(&bar[XB_TOPGEN]) == tg, bar);
      __builtin_amdgcn_fence(__ATOMIC_ACQUIRE, "agent");
      xb_add(&bar[XB_XGEN(b.x)], 1u);
      asm volatile("s_waitcnt vmcnt(0)" ::: "memory");
    } else {
      XB_SPIN(xb_ld(&bar[XB_XGEN(b.x)]) == gen, bar);
      __builtin_amdgcn_fence(__ATOMIC_ACQUIRE, "agent");
      asm volatile("s_waitcnt vmcnt(0)" ::: "memory");
    }
  }
  __syncthreads();
}

#if !MULTI
__global__ void __launch_bounds__(512) mega_kernel(Params p) {
  __shared__ __attribute__((aligned(16))) char smem[2 * STG];
  __shared__ uint4 xb_words;
  cg::grid_group grid = cg::this_grid();
  if (p.ws == nullptr) grid.sync();
  if (__builtin_amdgcn_workitem_id_x() == 0) xb_words = make_uint4(0u, 0u, 0u, 0u);
  __syncthreads();
  const XcdBarrier xb = xcd_barrier_post((unsigned*)(p.ws + W_BAR), (volatile LAS unsigned*)&xb_words);
#pragma nounroll
  for (int ph = 0; ph < NPHASE; ++ph) {
    long zoff;
    asm volatile("s_mov_b64 %0, 0" : "=s"(zoff));
    Params q;
#pragma unroll
    for (int i = 0; i < 27; ++i) q.in[i] = (const float*)((const char*)p.in[i] + zoff);
    q.out = (float*)((char*)p.out + zoff);
    q.ws = p.ws + zoff;
    run_phase(q, ph, smem);
    if (ph < NPHASE - 1) xcd_barrier(xb);
  }
}
#endif

extern "C" void kernel_launch(void* const* d_in, const int* in_sizes, int n_in, void* d_out, int out_size, void* d_ws,
                              size_t ws_size, hipStream_t stream) {
  Params p{};
  for (int i = 0; i < 27; ++i) p.in[i] = (const float*)d_in[i];
  p.out = (float*)d_out;
  p.ws = (char*)d_ws;
#if MULTI
  for (int ph = 0; ph < NPHASE; ++ph) hipLaunchKernelGGL(phase_kernel, dim3(512), dim3(256), 0, stream, p, ph);
#else
  static int grid_blocks = 0;
  if (!grid_blocks) {
    int dev = 0, cus = 0, per_cu = 0;
    hipGetDevice(&dev);
    hipDeviceGetAttribute(&cus, hipDeviceAttributeMultiprocessorCount, dev);
    hipOccupancyMaxActiveBlocksPerMultiprocessor(&per_cu, mega_kernel, 512, 0);
    if (per_cu > 1) per_cu = 1;
    grid_blocks = cus * per_cu;
  }
  hipMemsetAsync((char*)d_ws + W_BAR, 0, BAR_BYTES, stream);
  void* args[] = {&p};
  hipError_t e = hipLaunchCooperativeKernel((void*)mega_kernel, dim3(grid_blocks), dim3(512), args, 0, stream);
  if (e != hipSuccess) fprintf(stderr, "cooperative launch failed: %s (grid %d)\n", hipGetErrorString(e), grid_blocks);
#endif
}
```

```cpp
#include <hip/hip_runtime.h>
#include <hip/hip_cooperative_groups.h>
#include <cstdio>
namespace cg = cooperative_groups;

#ifndef MULTI
#define MULTI 0
#endif


#define DI __device__ __forceinline__
typedef unsigned short bf16_t;
using bf16x8 = __attribute__((ext_vector_type(8))) short;
using f32x16 = __attribute__((ext_vector_type(16))) float;
using f32x32 = __attribute__((ext_vector_type(32))) float;
using f32x8 = __attribute__((ext_vector_type(8))) float;
using f32x4 = __attribute__((ext_vector_type(4))) float;
using u32x16 = __attribute__((ext_vector_type(16))) unsigned;
using u32x8 = __attribute__((ext_vector_type(8))) unsigned;
using u32x4 = __attribute__((ext_vector_type(4))) unsigned;
using u32x2 = __attribute__((ext_vector_type(2))) unsigned;
#define MFMA(a, b, c) __builtin_amdgcn_mfma_f32_32x32x16_bf16((a), (b), (c), 0, 0, 0)

constexpr int NTOK = 12288, NCTX = 8192, NKR = 12800;
constexpr int LDX = 1024 + 64, LDH = 2816 + 64;
constexpr float EPS = 1e-6f;
constexpr float ALPHA = 1.4142135623730951f;
constexpr float LOG2E = 1.4426950408889634f;
constexpr float MLA_QS = 0.10206207261596575f * LOG2E;
constexpr float GQA_QS = 0.125f * LOG2E;

constexpr size_t O_Y = 0;
constexpr size_t O_CKV = 12582912;
constexpr size_t O_KPE = 14680064;
constexpr size_t O_GK = 15204352;
constexpr size_t O_GV = 17301504;
constexpr size_t O_HG = 19398656;

constexpr size_t al(size_t x) { return (x + 255) & ~(size_t)255; }
constexpr size_t W_WIN = 0;
constexpr size_t W_WUQ = al(W_WIN + 2ull * 2560 * LDX * 2);
constexpr size_t W_WUKV = al(W_WUQ + 2ull * 768 * 256 * 2);
constexpr size_t W_WOUT = al(W_WUKV + 2ull * 768 * 128 * 2);
constexpr size_t W_WFI = al(W_WOUT + 2ull * 1024 * LDX * 2);
constexpr size_t W_WFO = al(W_WFI + 2ull * 5632 * LDX * 2);
constexpr size_t W_ADAP = al(W_WFO + 2ull * 1024 * LDH * 2);
constexpr size_t W_ADAM = al(W_ADAP + 16ull * 2 * 3 * 6144 * 4);
constexpr size_t W_GB = al(W_ADAM + 2ull * 3 * 6144 * 4);
constexpr size_t W_STA = al(W_GB + 2ull * 2 * 3 * 2048 * 4);
constexpr size_t W_STB = al(W_STA + 12288ull * 32 * 4);
constexpr size_t W_ZH = al(W_STB + 12288ull * 32 * 4);
constexpr size_t W_MQ = al(W_ZH + 12288ull * 1280 * 4);
constexpr size_t W_MQSS = al(W_MQ + 12288ull * 256 * 2);
constexpr size_t W_CKVB = al(W_MQSS + 12288ull * 2 * 4);
constexpr size_t W_ZEND = al(W_CKVB + 12800ull * 128 * 2);
constexpr size_t W_HID = W_ZH;
static_assert(W_ZEND - W_ZH >= 12288ull * LDH * 2, "hidden alias");
constexpr size_t W_QM = W_ZEND;
constexpr size_t W_KM = al(W_QM + 12288ull * 576 * 2);
constexpr size_t W_VMT = al(W_KM + 12800ull * 576 * 2);
constexpr size_t W_QG = al(W_VMT + 384ull * 12800 * 2);
constexpr size_t W_KG = al(W_QG + 12288ull * 384 * 2);
constexpr size_t W_VGT = al(W_KG + 12800ull * 128 * 2);
constexpr size_t W_HKV = al(W_VGT + 128ull * 12800 * 2);
constexpr size_t W_HCD = al(W_HKV + 1536ull * 4096 * 4);
constexpr size_t W_MIX = al(W_HCD + 1536ull * 64 * 4);
constexpr size_t W_END = al(W_MIX + 12288ull * LDX * 2);
constexpr size_t W_ROPE = W_END;
constexpr size_t W_BAR = al(W_ROPE + 3072 * 4);
constexpr size_t BAR_BYTES = 3456 * 4 + 1024;
static_assert(W_BAR + BAR_BYTES <= 268435456ull, "workspace");

struct Params {
  const float* in[27];
  float* out;
  char* ws;
};
enum { I_XP = 0, I_XS, I_CCKV, I_CKPE, I_CGK, I_CGV, I_SHG, I_C, I_CCTX, I_WADA, I_BADA, I_WIN, I_HGLB, I_HGN, I_MQN, I_WUQ,
       I_MKVN, I_WUKV, I_GQN, I_GKN, I_WOUT, I_LN1G, I_LN1B, I_WFI, I_WFO, I_LN2G, I_LN2B };

constexpr int SMEM_BYTES = 73728;
constexpr int CS = 132;

DI int get_tid512() { int t = __builtin_amdgcn_workitem_id_x(); asm volatile("" : "+v"(t)); return t; }
DI int get_tid() { return get_tid512() & 255; }
DI int get_half() { return __builtin_amdgcn_readfirstlane(get_tid512() >> 8); }
DI int vbid() { return (int)blockIdx.x * 2 + get_half(); }
DI int vgrid() { return (int)gridDim.x * 2; }
DI float ld_dev(const float* p) { return __hip_atomic_load(p, __ATOMIC_RELAXED, __HIP_MEMORY_SCOPE_AGENT); }
DI unsigned f2bf(float x) {
  unsigned u = __float_as_uint(x);
  u += 0x7fffu + ((u >> 16) & 1u);
  return u >> 16;
}
typedef __bf16 bf16x2_t __attribute__((ext_vector_type(2)));
typedef float f32x2_t __attribute__((ext_vector_type(2)));
DI unsigned pack2(float a, float b) {
  f32x2_t v; v[0] = a; v[1] = b;
  return __builtin_bit_cast(unsigned, __builtin_convertvector(v, bf16x2_t));
}
DI float fexp2(float x) { return __builtin_amdgcn_exp2f(x); }
DI float flog2(float x) { return __builtin_amdgcn_logf(x); }
DI float frcp(float x) { return __builtin_amdgcn_rcpf(x); }
DI float fsigmoid(float x) { return frcp(1.f + fexp2(-x * 1.4426950408889634f)); }
DI float silu(float x) { return x * frcp(1.f + __builtin_amdgcn_exp2f(-x * 1.4426950408889634f)); }

DI void tokinfo(int t, int& v, int& b, int& s, int& kr) {
  if (t < NCTX) { v = 0; b = t >> 8; s = t & 255; kr = t; }
  else { int u = t - NCTX; b = u >> 11; s = u & 2047; v = 1 + b; kr = NCTX + b * 2304 + 256 + s; }
}

DI void gemm_core(const bf16_t* __restrict__ Ap, int lda, const bf16_t* __restrict__ Bp, int ldb, int K, char* smem) {
  const int tid = get_tid(), lane = tid & 63, w = tid >> 6, l32 = lane & 31, g = lane >> 5;
  const int wm = w >> 1, wn = w & 1;
  char* As = smem;
  char* Bs = smem + 18432;
  f32x16 acc[2][2];
#pragma unroll
  for (int i = 0; i < 2; ++i)
#pragma unroll
    for (int j = 0; j < 2; ++j)
#pragma unroll
      for (int e = 0; e < 16; ++e) acc[i][j][e] = 0.f;

  u32x16 rab, rb;
  const int kc8 = (tid & 7) * 8, r32 = tid >> 3;
  const int KT = K >> 6;
#define GEMM_PREFETCH(k0)                                                                                   \
  {                                                                                                         \
    _Pragma("unroll") for (int i = 0; i < 4; ++i) {                                                         \
      const u32x4 t = *(const u32x4*)(Ap + (size_t)(r32 + 32 * i) * lda + (k0) + kc8);                      \
      rab[i * 4 + 0] = t[0]; rab[i * 4 + 1] = t[1]; rab[i * 4 + 2] = t[2]; rab[i * 4 + 3] = t[3];           \
    }                                                                                                       \
    _Pragma("unroll") for (int i = 0; i < 4; ++i) {                                                         \
      const u32x4 t = *(const u32x4*)(Bp + (size_t)(r32 + 32 * i) * ldb + (k0) + kc8);                      \
      rb[i * 4 + 0] = t[0]; rb[i * 4 + 1] = t[1]; rb[i * 4 + 2] = t[2]; rb[i * 4 + 3] = t[3];               \
    }                                                                                                       \
  }
#define GEMM_STORE(buf)                                                                                     \
  {                                                                                                         \
    _Pragma("unroll") for (int i = 0; i < 4; ++i) {                                                         \
      u32x4 t; t[0] = rab[i * 4 + 0]; t[1] = rab[i * 4 + 1]; t[2] = rab[i * 4 + 2]; t[3] = rab[i * 4 + 3];  \
      *(u32x4*)(As + (buf) * 36864 + (r32 + 32 * i) * 144 + kc8 * 2) = t;                                   \
    }                                                                                                       \
    _Pragma("unroll") for (int i = 0; i < 4; ++i) {                                                         \
      u32x4 t; t[0] = rb[i * 4 + 0]; t[1] = rb[i * 4 + 1]; t[2] = rb[i * 4 + 2]; t[3] = rb[i * 4 + 3];      \
      *(u32x4*)(Bs + (buf) * 36864 + (r32 + 32 * i) * 144 + kc8 * 2) = t;                                   \
    }                                                                                                       \
  }
  GEMM_PREFETCH(0)
  GEMM_STORE(0)
  __syncthreads();
  for (int kt = 0; kt < KT; ++kt) {
    const int cur = kt & 1;
    if (kt + 1 < KT) {
      const int k0n = (kt + 1) << 6;
      GEMM_PREFETCH(k0n)
    }
    __builtin_amdgcn_sched_barrier(0);
    const char* Ac = As + cur * 36864;
    const char* Bc = Bs + cur * 36864;
#pragma unroll
    for (int ks = 0; ks < 4; ++ks) {
      const int ko = (ks * 16 + g * 8) * 2;
      bf16x8 a0 = *(const bf16x8*)(Ac + (wm * 64 + l32) * 144 + ko);
      bf16x8 a1 = *(const bf16x8*)(Ac + (wm * 64 + 32 + l32) * 144 + ko);
      bf16x8 b0 = *(const bf16x8*)(Bc + (wn * 64 + l32) * 144 + ko);
      bf16x8 b1 = *(const bf16x8*)(Bc + (wn * 64 + 32 + l32) * 144 + ko);
      acc[0][0] = MFMA(a0, b0, acc[0][0]);
      acc[0][1] = MFMA(a0, b1, acc[0][1]);
      acc[1][0] = MFMA(a1, b0, acc[1][0]);
      acc[1][1] = MFMA(a1, b1, acc[1][1]);
    }
    __builtin_amdgcn_sched_barrier(0);
    if (kt + 1 < KT) GEMM_STORE(cur ^ 1)
    __syncthreads();
  }
  float* Cs = (float*)smem;
#pragma unroll
  for (int mt = 0; mt < 2; ++mt)
#pragma unroll
    for (int nt = 0; nt < 2; ++nt)
#pragma unroll
      for (int j = 0; j < 16; ++j) {
        int row = wm * 64 + mt * 32 + (j & 3) + 8 * (j >> 2) + 4 * g;
        Cs[row * CS + wn * 64 + nt * 32 + l32] = acc[mt][nt][j];
      }
  __syncthreads();
}


constexpr int STG = 73728;
template <int MT>
DI void gemm512_main(const bf16_t* __restrict__ Ap, int lda, const bf16_t* __restrict__ Bp, int ldb, int K, char* smem,
                     f32x16 (&acc)[MT][2]) {
  const int tid = get_tid512(), lane = tid & 63, w = tid >> 6, l32 = lane & 31, g = lane >> 5;
  const int wm = w >> 2, wn = w & 3;
#pragma unroll
  for (int i = 0; i < MT; ++i)
#pragma unroll
    for (int j = 0; j < 2; ++j)
#pragma unroll
      for (int e = 0; e < 16; ++e) acc[i][j][e] = 0.f;
  u32x16 ra, rb;
  const int kc8 = (tid & 7) * 8, r64 = tid >> 3;
  const int KT = K >> 6;
  const unsigned aoff = (unsigned)(r64 * lda + kc8) * 2u, astep = (unsigned)(64 * lda) * 2u;
  const unsigned boff = (unsigned)(r64 * ldb + kc8) * 2u, bstep = (unsigned)(64 * ldb) * 2u;
#define G512_PREFETCH(k0)                                                                                   \
  {                                                                                                         \
    _Pragma("unroll") for (int i = 0; i < MT; ++i) {                                                        \
      const u32x4 t = *(const u32x4*)(Ap + (size_t)(r64 + 64 * i) * lda + (k0) + kc8);                      \
      ra[i * 4 + 0] = t[0]; ra[i * 4 + 1] = t[1]; ra[i * 4 + 2] = t[2]; ra[i * 4 + 3] = t[3];               \
    }                                                                                                       \
    _Pragma("unroll") for (int i = 0; i < 4; ++i) {                                                         \
      const u32x4 t = *(const u32x4*)(Bp + (size_t)(r64 + 64 * i) * ldb + (k0) + kc8);                      \
      rb[i * 4 + 0] = t[0]; rb[i * 4 + 1] = t[1]; rb[i * 4 + 2] = t[2]; rb[i * 4 + 3] = t[3];               \
    }                                                                                                       \
  }
#define G512_STORE(buf)                                                                                     \
  {                                                                                                         \
    _Pragma("unroll") for (int i = 0; i < MT; ++i) {                                                        \
      u32x4 t; t[0] = ra[i * 4 + 0]; t[1] = ra[i * 4 + 1]; t[2] = ra[i * 4 + 2]; t[3] = ra[i * 4 + 3];      \
      *(u32x4*)(smem + (buf) * STG + (r64 + 64 * i) * 144 + kc8 * 2) = t;                                   \
    }                                                                                                       \
    _Pragma("unroll") for (int i = 0; i < 4; ++i) {                                                         \
      u32x4 t; t[0] = rb[i * 4 + 0]; t[1] = rb[i * 4 + 1]; t[2] = rb[i * 4 + 2]; t[3] = rb[i * 4 + 3];      \
      *(u32x4*)(smem + (buf) * STG + 36864 + (r64 + 64 * i) * 144 + kc8 * 2) = t;                           \
    }                                                                                                       \
  }
#define G512_LOAD_PART(i, k0)                                                                               \
  {                                                                                                         \
    if ((i) < MT) {                                                                                         \
    const u32x4 ta = *(const u32x4*)((const char*)Ap + (size_t)(unsigned)((k0) * 2) + (aoff + (unsigned)(i) * astep)); \
    ra[(i) * 4 + 0] = ta[0]; ra[(i) * 4 + 1] = ta[1]; ra[(i) * 4 + 2] = ta[2]; ra[(i) * 4 + 3] = ta[3]; }   \
    const u32x4 tb = *(const u32x4*)((const char*)Bp + (size_t)(unsigned)((k0) * 2) + (boff + (unsigned)(i) * bstep)); \
    rb[(i) * 4 + 0] = tb[0]; rb[(i) * 4 + 1] = tb[1]; rb[(i) * 4 + 2] = tb[2]; rb[(i) * 4 + 3] = tb[3];     \
  }
#define G512_STORE_PART(i, buf)                                                                             \
  {                                                                                                         \
    if ((i) < MT) {                                                                                         \
    u32x4 ta; ta[0] = ra[(i) * 4 + 0]; ta[1] = ra[(i) * 4 + 1]; ta[2] = ra[(i) * 4 + 2]; ta[3] = ra[(i) * 4 + 3]; \
    *(u32x4*)(smem + (buf) * STG + (r64 + 64 * (i)) * 144 + kc8 * 2) = ta; }                                \
    u32x4 tb; tb[0] = rb[(i) * 4 + 0]; tb[1] = rb[(i) * 4 + 1]; tb[2] = rb[(i) * 4 + 2]; tb[3] = rb[(i) * 4 + 3]; \
    *(u32x4*)(smem + (buf) * STG + 36864 + (r64 + 64 * (i)) * 144 + kc8 * 2) = tb;                          \
  }
  G512_PREFETCH(0)
  G512_STORE(0)
  if (KT > 1) { G512_PREFETCH(64) }
  __syncthreads();
  for (int kt = 0; kt < KT; ++kt) {
    const int cur = kt & 1;
    const char* Ac = smem + cur * STG;
    const char* Bc = Ac + 36864;
    bf16x8 fa[MT], fb0, fb1;
    const char* Ar = Ac + (wm * (MT * 32) + l32) * 144 + g * 16;
    const char* Br = Bc + (wn * 64 + l32) * 144 + g * 16;
#pragma unroll
    for (int mt = 0; mt < MT; ++mt) fa[mt] = *(const bf16x8*)(Ar + mt * 32 * 144);
    fb0 = *(const bf16x8*)(Br);
    fb1 = *(const bf16x8*)(Br + 32 * 144);
#pragma unroll
    for (int ks = 0; ks < 4; ++ks) {
#pragma unroll
      for (int mt = 0; mt < MT; ++mt) {
        acc[mt][0] = MFMA(fa[mt], fb0, acc[mt][0]);
        acc[mt][1] = MFMA(fa[mt], fb1, acc[mt][1]);
        if (ks < 3) fa[mt] = *(const bf16x8*)(Ar + mt * 32 * 144 + (ks + 1) * 32);
      }
      if (ks < 3) {
        fb0 = *(const bf16x8*)(Br + (ks + 1) * 32);
        fb1 = *(const bf16x8*)(Br + 32 * 144 + (ks + 1) * 32);
      }
      if (kt + 1 < KT) G512_STORE_PART(ks, cur ^ 1)
      if (kt + 2 < KT) { const int k0n = (kt + 2) << 6; G512_LOAD_PART(ks, k0n) }
      __builtin_amdgcn_sched_barrier(0);
    }
    __syncthreads();
  }
}
template <int MT>
DI void gemm512_stage(const f32x16 (&acc)[MT][2], int h, char* smem) {
  const int tid = get_tid512(), lane = tid & 63, w = tid >> 6, l32 = lane & 31, g = lane >> 5;
  const int wm = w >> 2, wn = w & 3;
  if (wm == h) {
    float* Cs = (float*)(smem + (wn >> 1) * STG);
#pragma unroll
    for (int mt = 0; mt < MT; ++mt)
#pragma unroll
      for (int nt = 0; nt < 2; ++nt)
#pragma unroll
        for (int j = 0; j < 16; ++j) {
          const int row = mt * 32 + (j & 3) + 8 * (j >> 2) + 4 * g;
          Cs[row * CS + (wn & 1) * 64 + nt * 32 + l32] = acc[mt][nt][j];
        }
  }
  __syncthreads();
}
struct TileWalk512 {
  int x, nb, mtx, total, q;
  DI TileWalk512(int MT, int NT) {
    x = blockIdx.x & 7; nb = gridDim.x >> 3;
    mtx = (MT - x + 7) >> 3; total = mtx * NT; q = blockIdx.x >> 3;
  }
  DI bool next(int& mt, int& nt) {
    if (q >= total) return false;
    mt = (q % mtx) * 8 + x; nt = q / mtx; q += nb;
    return true;
  }
};

DI float4 rope4(float4 v, float4 pv, int i0, bool first, int pos, const float* __restrict__ tab, int half) {
  const float4 cs = *(const float4*)(tab + pos * half + i0);
  const float4 sn = *(const float4*)(tab + 64 * half + pos * half + i0);
  float4 o;
  if (first) { o.x = v.x * cs.x - pv.x * sn.x; o.y = v.y * cs.y - pv.y * sn.y; o.z = v.z * cs.z - pv.z * sn.z; o.w = v.w * cs.w - pv.w * sn.w; }
  else { o.x = pv.x * sn.x + v.x * cs.x; o.y = pv.y * sn.y + v.y * cs.y; o.z = pv.z * sn.z + v.z * cs.z; o.w = pv.w * sn.w + v.w * cs.w; }
  return o;
}
DI float4 rope4cs(float4 v, float4 pv, bool first, float4 cs, float4 sn) {
  float4 o;
  if (first) { o.x = v.x * cs.x - pv.x * sn.x; o.y = v.y * cs.y - pv.y * sn.y; o.z = v.z * cs.z - pv.z * sn.z; o.w = v.w * cs.w - pv.w * sn.w; }
  else { o.x = pv.x * sn.x + v.x * cs.x; o.y = pv.y * sn.y + v.y * cs.y; o.z = pv.z * sn.z + v.z * cs.z; o.w = pv.w * sn.w + v.w * cs.w; }
  return o;
}
DI float4 shfl4(float4 v, int m) {
  return make_float4(__shfl_xor(v.x, m), __shfl_xor(v.y, m), __shfl_xor(v.z, m), __shfl_xor(v.w, m));
}
DI void store_bf4(bf16_t* dst, float4 v) {
  uint2 pk; pk.x = pack2(v.x, v.y); pk.y = pack2(v.z, v.w);
  *(uint2*)dst = pk;
}

struct WpDesc { int mat, K, Nsrc, ldw, k0, n0, l; const float* W; bf16_t* WT; };
DI WpDesc wprep_decode(const Params& p, int item) {
  WpDesc d;
  int l = item / 3048, rem = item % 3048;
  int Np, NT;
  if (rem < 608) { d.mat = 0; d.K = 1024; Np = 2560; d.Nsrc = 2336; NT = 38; d.W = p.in[I_WIN]; d.WT = (bf16_t*)(p.ws + W_WIN); d.ldw = LDX; }
  else if ((rem -= 608) < 48) { d.mat = 1; d.K = 256; Np = 768; d.Nsrc = 576; NT = 12; d.W = p.in[I_WUQ]; d.WT = (bf16_t*)(p.ws + W_WUQ); d.ldw = 256; }
  else if ((rem -= 48) < 24) { d.mat = 2; d.K = 128; Np = 768; d.Nsrc = 768; NT = 12; d.W = p.in[I_WUKV]; d.WT = (bf16_t*)(p.ws + W_WUKV); d.ldw = 128; }
  else if ((rem -= 24) < 256) { d.mat = 3; d.K = 1024; Np = 1024; d.Nsrc = 1024; NT = 16; d.W = p.in[I_WOUT]; d.WT = (bf16_t*)(p.ws + W_WOUT); d.ldw = LDX; }
  else if ((rem -= 256) < 1408) { d.mat = 4; d.K = 1024; Np = 5632; d.Nsrc = 5632; NT = 88; d.W = p.in[I_WFI]; d.WT = (bf16_t*)(p.ws + W_WFI); d.ldw = LDX; }
  else { rem -= 1408; d.mat = 5; d.K = 2816; Np = 1024; d.Nsrc = 1024; NT = 16; d.W = p.in[I_WFO]; d.WT = (bf16_t*)(p.ws + W_WFO); d.ldw = LDH; }
  d.k0 = (rem / NT) * 64; d.n0 = (rem % NT) * 64; d.l = l;
  d.W += (size_t)l * d.K * d.Nsrc;
  d.WT += (size_t)l * Np * d.ldw;
  return d;
}
DI int wprep_src(int mat, int n) {
  if (mat == 0) return (n < 1664) ? n : (n < 2304 ? n + 32 : (n < 2336 ? n - 640 : -1));
  if (mat == 1) { int h = n >> 7, jj = n & 127; return (jj < 96) ? h * 96 + jj : -1; }
  if (mat == 4) { int q = n >> 6, ww = n & 63; return (ww < 32) ? q * 32 + ww : 2816 + q * 32 + ww - 32; }
  return n;
}
DI void wprep_pair(const Params& p, int item, char* smem) {
  const int tid = get_tid();
  float* tile = (float*)smem;
  const WpDesc d0 = wprep_decode(p, item), d1 = wprep_decode(p, item + 1);
  const int j = tid & 63, i0 = tid >> 6;
  const int s0 = wprep_src(d0.mat, d0.n0 + j), s1 = wprep_src(d1.mat, d1.n0 + j);
  f32x16 v0, v1;
#pragma unroll
  for (int ps = 0; ps < 16; ++ps) {
    const int i = i0 + 4 * ps;
    v0[ps] = (s0 >= 0) ? d0.W[(size_t)(d0.k0 + i) * d0.Nsrc + s0] : 0.f;
  }
#pragma unroll
  for (int ps = 0; ps < 16; ++ps) {
    const int i = i0 + 4 * ps;
    v1[ps] = (s1 >= 0) ? d1.W[(size_t)(d1.k0 + i) * d1.Nsrc + s1] : 0.f;
  }
#pragma unroll
  for (int ps = 0; ps < 16; ++ps) {
    const int i = i0 + 4 * ps;
    float a = v0[ps], b = v1[ps];
    if (d0.mat == 1) a *= p.in[I_MQN][d0.l * 256 + d0.k0 + i];
    if (d1.mat == 1) b *= p.in[I_MQN][d1.l * 256 + d1.k0 + i];
    tile[i * 65 + j] = a;
    tile[4160 + i * 65 + j] = b;
  }
  __syncthreads();
  {
    const int ik2 = (tid & 31) * 2;
#pragma unroll
    for (int ps = 0; ps < 8; ++ps) {
      const int jn = (tid >> 5) + 8 * ps;
      *(unsigned*)(d0.WT + (size_t)(d0.n0 + jn) * d0.ldw + d0.k0 + ik2) = pack2(tile[ik2 * 65 + jn], tile[(ik2 + 1) * 65 + jn]);
      *(unsigned*)(d1.WT + (size_t)(d1.n0 + jn) * d1.ldw + d1.k0 + ik2) = pack2(tile[4160 + ik2 * 65 + jn], tile[4160 + (ik2 + 1) * 65 + jn]);
    }
  }
  __syncthreads();
}

DI void ada_item(const Params& p, int item, char* smem) {
  const int tid = get_tid();
  float* sc = (float*)smem;
  const int l = item / 384, rem = item % 384, kc = rem / 24, nc = rem % 24;
  if (tid < 192) {
    int v = tid >> 6, kk = tid & 63, k = kc * 64 + kk;
    float cv = (v == 0) ? p.in[I_CCTX][k] : p.in[I_C][(v - 1) * 1024 + k];
    sc[tid] = silu(cv);
  }
  __syncthreads();
  const int n = nc * 256 + tid;
  const float* W = p.in[I_WADA] + (size_t)l * 1024 * 6144 + (size_t)(kc * 64) * 6144 + n;
  float a0 = 0.f, a1 = 0.f, a2 = 0.f;
#pragma unroll 8
  for (int kk = 0; kk < 64; ++kk) {
    float wv = W[(size_t)kk * 6144];
    a0 += sc[kk] * wv; a1 += sc[64 + kk] * wv; a2 += sc[128 + kk] * wv;
  }
  float* ap = (float*)(p.ws + W_ADAP);
  ap[((kc * 2 + l) * 3 + 0) * 6144 + n] = a0;
  ap[((kc * 2 + l) * 3 + 1) * 6144 + n] = a1;
  ap[((kc * 2 + l) * 3 + 2) * 6144 + n] = a2;
  __syncthreads();
}

DI void phase0(const Params& p, char* smem) {
  for (int it = vbid(); it < 768; it += vgrid()) ada_item(p, it, smem);
}
DI void wprep_all(const Params& p, char* smem) {
  for (int it = vbid(); it < 3048; it += vgrid()) wprep_pair(p, it * 2, smem);
}

DI void phase0b(const Params& p) {
  {
    float* rt = (float*)(p.ws + W_ROPE);
    for (int i = vbid() * 256 + get_tid(); i < 1536; i += vgrid() * 256) {
      int half, pos, fi; float* base;
      if (i < 1024) { half = 16; pos = i >> 4; fi = i & 15; base = rt; }
      else { const int k = i - 1024; half = 8; pos = k >> 3; fi = k & 7; base = rt + 2048; }
      const float fr = exp2f(-(float)fi / (float)half * 13.287712379549449f);
      const float ang = (float)pos * fr;
      base[pos * half + fi] = __cosf(ang);
      base[64 * half + pos * half + fi] = __sinf(ang);
    }
  }
  const float* ap = (const float*)(p.ws + W_ADAP);
  float* am = (float*)(p.ws + W_ADAM);
  float* gb = (float*)(p.ws + W_GB);
  for (int i = vbid() * 256 + get_tid(); i < 2 * 3 * 1024; i += vgrid() * 256) {
    const int l = i / 3072, v = (i % 3072) / 1024, k = i % 1024;
    f32x8 m;
#pragma unroll
    for (int j = 0; j < 6; ++j) {
      float s = p.in[I_BADA][l * 6144 + j * 1024 + k];
      for (int kc = 0; kc < 16; ++kc) s += ap[((kc * 2 + l) * 3 + v) * 6144 + j * 1024 + k];
      m[j] = s;
      am[(l * 3 + v) * 6144 + j * 1024 + k] = s;
    }
    float lg = 1.f, lb = 0.f;
    if (l == 1) { lg = p.in[I_LN2G][k]; lb = p.in[I_LN2B][k]; }
    gb[((l * 2 + 0) * 3 + v) * 2048 + k] = lg * (1.f + m[1]);
    gb[((l * 2 + 0) * 3 + v) * 2048 + 1024 + k] = lb * (1.f + m[1]) + m[0];
    lg = p.in[I_LN1G][l * 1024 + k]; lb = p.in[I_LN1B][l * 1024 + k];
    gb[((l * 2 + 1) * 3 + v) * 2048 + k] = lg * (1.f + m[4]);
    gb[((l * 2 + 1) * 3 + v) * 2048 + 1024 + k] = lb * (1.f + m[4]) + m[3];
  }
}

struct TileWalk {
  int x, j, nb, mtx, total, q;
  DI TileWalk(int MT, int NT) {
    x = blockIdx.x & 7; j = blockIdx.x >> 3; nb = gridDim.x >> 3;
    mtx = (MT - x + 7) >> 3; total = mtx * NT; q = j;
  }
  DI bool next(int& mt, int& nt) {
    if (q >= total) return false;
    mt = (q % mtx) * 8 + x; nt = q / mtx; q += nb;
    return true;
  }
};

DI void p1_epilogue(const Params& p, int l, int m0, int nt, const float* Cs) {
  const int tid = get_tid(), cl = tid & 31, c4 = cl * 4, rr = tid >> 5;
  char* ws = p.ws;
  float* out = p.out;
  const bool den_tile = m0 >= NCTX;
  const bool ropeG = den_tile && nt >= 13 && nt <= 16, ropeM = den_tile && nt == 18;
  float4 ggc = make_float4(1.f, 1.f, 1.f, 1.f);
  if (nt == 12) ggc = *(const float4*)(p.in[I_MKVN] + l * 128 + c4);
  else if (nt >= 13 && nt <= 16) ggc = *(const float4*)(p.in[nt == 16 ? I_GKN : I_GQN] + l * 64 + (c4 & 63));
  const float* rtab = (const float*)(ws + W_ROPE) + (ropeM ? 2048 : 0);
  const int rhalf = ropeM ? 8 : 16;
  const int rd = ropeM ? (c4 & 31) : (c4 & 63);
  const int rblk = ropeM ? (rd >> 4) : (rd >> 5), ri0 = ropeM ? (rd & 7) : (rd & 15);
  float4 rcn = make_float4(1.f, 1.f, 1.f, 1.f), rsn = make_float4(0.f, 0.f, 0.f, 0.f);
  if (ropeG || ropeM) {
    const int s0 = (m0 + rr - NCTX) & 2047;
    const int pos = (rblk == 0) ? (s0 >> 6) : (s0 & 63);
    rcn = *(const float4*)(rtab + pos * rhalf + ri0);
    rsn = *(const float4*)(rtab + 64 * rhalf + pos * rhalf + ri0);
  }
  for (int ps = 0; ps < 16; ++ps) {
    const int r = ps * 8 + rr, t = m0 + r;
    float4 v = *(const float4*)(Cs + r * CS + c4);
    int vv, b, s, kr; tokinfo(t, vv, b, s, kr);
    const bool den = t >= NCTX;
    const float4 rc = rcn, rs = rsn;
    if ((ropeG || ropeM) && ps < 15) {
      const int s1 = (t + 8 - NCTX) & 2047;
      const int pos = (rblk == 0) ? (s1 >> 6) : (s1 & 63);
      rcn = *(const float4*)(rtab + pos * rhalf + ri0);
      rsn = *(const float4*)(rtab + 64 * rhalf + pos * rhalf + ri0);
    }
    if (nt < 10) {
      *(float4*)((float*)(ws + W_ZH) + (size_t)t * 1280 + nt * 128 + c4) = v;
    } else if (nt < 12) {
      store_bf4((bf16_t*)(ws + W_MQ) + (size_t)t * 256 + (nt - 10) * 128 + c4, v);
      float ss = v.x * v.x + v.y * v.y + v.z * v.z + v.w * v.w;
      ss += __shfl_xor(ss, 1); ss += __shfl_xor(ss, 2); ss += __shfl_xor(ss, 4); ss += __shfl_xor(ss, 8); ss += __shfl_xor(ss, 16);
      if (cl == 0) ((float*)(ws + W_MQSS))[t * 2 + (nt - 10)] = ss;
    } else if (nt == 12) {
      float ss = v.x * v.x + v.y * v.y + v.z * v.z + v.w * v.w;
      ss += __shfl_xor(ss, 1); ss += __shfl_xor(ss, 2); ss += __shfl_xor(ss, 4); ss += __shfl_xor(ss, 8); ss += __shfl_xor(ss, 16);
      const float sc = rsqrtf(ss * (1.f / 128.f) + EPS);
      const float4 gg = ggc;
      float4 o = make_float4(v.x * sc * gg.x, v.y * sc * gg.y, v.z * sc * gg.z, v.w * sc * gg.w);
      store_bf4((bf16_t*)(ws + W_CKVB) + (size_t)kr * 128 + c4, o);
      if (!den) *(float4*)(out + O_CKV + ((size_t)(b * 2 + l) * 256 + s) * 128 + c4) = o;
    } else if (nt < 17) {
      float ss = v.x * v.x + v.y * v.y + v.z * v.z + v.w * v.w;
      ss += __shfl_xor(ss, 1); ss += __shfl_xor(ss, 2); ss += __shfl_xor(ss, 4); ss += __shfl_xor(ss, 8);
      const float sc = rsqrtf(ss * (1.f / 64.f) + EPS);
      const int d = c4 & 63, hh = c4 >> 6;
      const float4 gg = ggc;
      float4 o = make_float4(v.x * sc * gg.x, v.y * sc * gg.y, v.z * sc * gg.z, v.w * sc * gg.w);
      if (nt == 16 && !den) *(float4*)(out + O_GK + ((size_t)(b * 2 + l) * 256 + s) * 128 + c4) = o;
      float4 po = shfl4(o, 4);
      if (den) o = rope4cs(o, po, (d & 31) < 16, rc, rs);
      if (nt == 16) {
        store_bf4((bf16_t*)(ws + W_KG) + (size_t)kr * 128 + c4, o);
      } else {
        o.x *= GQA_QS; o.y *= GQA_QS; o.z *= GQA_QS; o.w *= GQA_QS;
        store_bf4((bf16_t*)(ws + W_QG) + (size_t)t * 384 + ((nt - 13) * 2 + hh) * 64 + d, o);
      }
    } else if (nt == 17) {
      if (!den) *(float4*)(out + O_GV + ((size_t)(b * 2 + l) * 256 + s) * 128 + c4) = v;
    } else {
      float4 pv = shfl4(v, 2);
      float4 o = v;
      if (den) o = rope4cs(v, pv, (c4 & 15) < 8, rc, rs);
      if (c4 < 32) {
        if (!den) *(float4*)(out + O_KPE + ((size_t)(b * 2 + l) * 256 + s) * 32 + c4) = v;
        bf16_t* km = (bf16_t*)(ws + W_KM) + (size_t)kr * 576 + 64 + c4;
#pragma unroll
        for (int h = 0; h < 6; ++h) store_bf4(km + h * 96, o);
      }
    }
  }
  if (nt == 17) {
    int vv, b, s, kr0; tokinfo(m0, vv, b, s, kr0);
    const int r2 = (tid & 63) * 2;
    bf16_t* vgt = (bf16_t*)(ws + W_VGT);
    for (int i = 0; i < 32; ++i) {
      const int c = (tid >> 6) + 4 * i;
      unsigned pk = pack2(Cs[r2 * CS + c], Cs[(r2 + 1) * CS + c]);
      *(unsigned*)(vgt + (size_t)c * NKR + kr0 + r2) = pk;
    }
  }
}

DI void phase1(const Params& p, int l, char* smem) {
  const bf16_t* WT = (const bf16_t*)(p.ws + W_WIN) + (size_t)l * 2560 * LDX;
  TileWalk512 tw(48, 10);
  int mt, nt2;
  const int hf = get_half();
  while (tw.next(mt, nt2)) {
    const int mbase = mt * 256;
    f32x16 acc[4][2];
    gemm512_main<4>((const bf16_t*)(p.ws + W_MIX) + (size_t)mbase * LDX, LDX, WT + (size_t)nt2 * 256 * LDX, LDX, 1024, smem, acc);
#pragma nounroll
    for (int hh = 0; hh < 2; ++hh) {
      gemm512_stage<4>(acc, hh, smem);
      const int nt = nt2 * 2 + hf;
      if (nt < 19) p1_epilogue(p, l, mbase + hh * 128, nt, (const float*)(smem + hf * STG));
      __syncthreads();
    }
  }
  const int gt = vbid() * 256 + get_tid(), gs = vgrid() * 256;
  for (int i = gt; i < 65536; i += gs) {
    const int b = i >> 15, k = (i >> 7) & 255, j = i & 127;
    const int kr = NCTX + b * 2304 + k;
    const size_t src = ((size_t)(b * 2 + l) * 256 + k) * 128 + j;
    ((bf16_t*)(p.ws + W_CKVB))[(size_t)kr * 128 + j] = (bf16_t)f2bf(p.in[I_CCKV][src]);
    ((bf16_t*)(p.ws + W_KG))[(size_t)kr * 128 + j] = (bf16_t)f2bf(p.in[I_CGK][src]);
  }
  for (int i = gt; i < 65536; i += gs) {
    const int b = i >> 15, j = (i >> 8) & 127, k = i & 255;
    const int kr = NCTX + b * 2304 + k;
    ((bf16_t*)(p.ws + W_VGT))[(size_t)j * NKR + kr] = (bf16_t)f2bf(p.in[I_CGV][((size_t)(b * 2 + l) * 256 + k) * 128 + j]);
  }
  for (int i = gt; i < 2 * 256 * 6 * 32; i += gs) {
    const int j = i & 31, h = (i >> 5) % 6, k = (i / 192) & 255, b = i / (192 * 256);
    const int kr = NCTX + b * 2304 + k;
    ((bf16_t*)(p.ws + W_KM))[(size_t)kr * 576 + h * 96 + 64 + j] = (bf16_t)f2bf(p.in[I_CKPE][((size_t)(b * 2 + l) * 256 + k) * 32 + j]);
  }
}

using f32x4v = __attribute__((ext_vector_type(4))) float;
#define MFMA16(a, b, c) __builtin_amdgcn_mfma_f32_16x16x32_bf16((a), (b), (c), 0, 0, 0)
struct HgSmem {
  float sQ[16 * 68], sK[16 * 68], sBC[16 * 68];
  float sO[64 * 64], sCD[64];
  bf16_t sIT[64 * 24];
  bf16_t sKT[64 * 24];
  bf16_t sQB[16 * 72];
  bf16_t sAB[16 * 24];
  bf16_t sST[64 * 72];
};
static_assert(sizeof(HgSmem) <= SMEM_BYTES, "hg smem");
DI bf16_t tobf(float x) { return (bf16_t)(pack2(x, 0.f) & 0xffffu); }

template <bool EMIT>
DI void hgrn_chunk(const Params& p, int l, int tbase, int h, int dir, int c, f32x4v (&S)[4], float& cdtot, HgSmem& sm, bool first_dir) {
  const int tid = get_tid(), lane = tid & 63, w = tid >> 6, n16 = lane & 15, q4 = lane >> 4;
  const float* zh = (const float*)(p.ws + W_ZH);
  const int kk = tid & 63, jq = tid >> 6;
  float lb = 0.f;
  if (l == 1) {
    float a0 = p.in[I_HGLB][(0 * 2 + dir) * 256 + h * 64 + kk], a1 = p.in[I_HGLB][(1 * 2 + dir) * 256 + h * 64 + kk];
    lb = fsigmoid(a1 - a0);
  }
  cdtot = 1.f;
  if (EMIT) {
    __syncthreads();
#pragma unroll
    for (int nt = 0; nt < 4; ++nt) {
      uint2 pk; pk.x = pack2(S[nt][0], S[nt][1]); pk.y = pack2(S[nt][2], S[nt][3]);
      *(uint2*)(&sm.sST[(16 * nt + n16) * 72 + 16 * w + 4 * q4]) = pk;
    }
  }
  f32x4 pq, pf, pi;
#define HG_LOAD(scx)                                                                         \
  {                                                                                          \
    _Pragma("unroll") for (int i = 0; i < 4; ++i) {                                          \
      const int j = jq + 4 * i;                                                              \
      const int pos = c * 64 + (scx) * 16 + (dir ? 15 - j : j);                              \
      const float* zr = zh + (size_t)(tbase + pos) * 1280 + h * 64 + kk;                     \
      pq[i] = zr[0]; pf[i] = zr[256 * (1 + dir)]; pi[i] = zr[768];                           \
    }                                                                                        \
  }
  HG_LOAD(dir ? 3 : 0)
  bf16x8 zero8;
#pragma unroll
  for (int e = 0; e < 8; ++e) zero8[e] = 0;
  for (int scI = 0; scI < 4; ++scI) {
    const int sc = dir ? 3 - scI : scI;
    __syncthreads();
#pragma unroll
    for (int i = 0; i < 4; ++i) {
      const int j = jq + 4 * i;
      const float hq = pq[i], hf = pf[i], hi = pi[i];
      const float e = fexp2(-hf * LOG2E);
      const float sig = frcp(1.f + e);
      const float sign = e * sig;
      const float f = lb + (1.f - lb) * sig;
      sm.sQ[j * 68 + kk] = silu(hq) * 0.125f;
      sm.sK[j * 68 + kk] = (1.f - lb) * sign;
      sm.sBC[j * 68 + kk] = flog2(fmaxf(f, 1e-30f));
      sm.sIT[kk * 24 + j] = tobf(hi);
    }
    if (scI < 3) { const int scn = dir ? 2 - scI : scI + 1; HG_LOAD(scn) }
    __syncthreads();
    if (tid < 64) {
      float run = 0.f;
#pragma unroll
      for (int j = 0; j < 16; ++j) { run += sm.sBC[j * 68 + tid]; sm.sBC[j * 68 + tid] = run; }
      const float cd = fexp2(run);
      sm.sCD[tid] = cd;
      cdtot *= cd;
    }
    __syncthreads();
    if (EMIT) {
      const int j = tid >> 4, s = tid & 15;
      float a = 0.f;
      if (s <= j) {
#pragma unroll 4
        for (int k = 0; k < 64; k += 4) {
          const float4 q4v = *(const float4*)(&sm.sQ[j * 68 + k]), k4 = *(const float4*)(&sm.sK[s * 68 + k]);
          const float4 bj = *(const float4*)(&sm.sBC[j * 68 + k]), bs = *(const float4*)(&sm.sBC[s * 68 + k]);
          a += q4v.x * k4.x * fexp2(bj.x - bs.x) + q4v.y * k4.y * fexp2(bj.y - bs.y)
             + q4v.z * k4.z * fexp2(bj.z - bs.z) + q4v.w * k4.w * fexp2(bj.w - bs.w);
        }
      }
      sm.sAB[(dir ? 15 - j : j) * 24 + s] = tobf(a);
    }
    {
#pragma unroll
      for (int i = 0; i < 4; ++i) {
        const int j = jq + 4 * i;
        const float bc = sm.sBC[j * 68 + kk], bl = sm.sBC[15 * 68 + kk];
        if (EMIT) sm.sQB[(dir ? 15 - j : j) * 72 + kk] = tobf(sm.sQ[j * 68 + kk] * fexp2(bc));
        sm.sKT[kk * 24 + j] = tobf(sm.sK[j * 68 + kk] * fexp2(bl - bc));
      }
    }
    __syncthreads();
    if (EMIT) {
      f32x4v o;
      o[0] = 0.f; o[1] = 0.f; o[2] = 0.f; o[3] = 0.f;
      const bf16x8 bi = *(const bf16x8*)(&sm.sIT[(16 * w + n16) * 24 + 8 * (q4 & 1)]);
      const bf16x8 aa = (q4 < 2) ? *(const bf16x8*)(&sm.sAB[n16 * 24 + 8 * (q4 & 1)]) : zero8;
      o = MFMA16(aa, bi, o);
#pragma unroll
      for (int ks = 0; ks < 2; ++ks) {
        const bf16x8 aq = *(const bf16x8*)(&sm.sQB[n16 * 72 + 32 * ks + 8 * q4]);
        const bf16x8 bs = *(const bf16x8*)(&sm.sST[(16 * w + n16) * 72 + 32 * ks + 8 * q4]);
        o = MFMA16(aq, bs, o);
      }
#pragma unroll
      for (int r = 0; r < 4; ++r) {
        float* op = &sm.sO[(sc * 16 + 4 * q4 + r) * 64 + 16 * w + n16];
        if (first_dir) *op = o[r]; else *op += o[r];
      }
    }
    {
      const f32x4 cd4 = *(const f32x4*)(&sm.sCD[16 * w + 4 * q4]);
      const bf16x8 ak = (q4 < 2) ? *(const bf16x8*)(&sm.sKT[(16 * w + n16) * 24 + 8 * (q4 & 1)]) : zero8;
#pragma unroll
      for (int nt = 0; nt < 4; ++nt) {
        const bf16x8 bi = *(const bf16x8*)(&sm.sIT[(16 * nt + n16) * 24 + 8 * (q4 & 1)]);
        f32x4v cc;
        cc[0] = S[nt][0] * cd4[0]; cc[1] = S[nt][1] * cd4[1]; cc[2] = S[nt][2] * cd4[2]; cc[3] = S[nt][3] * cd4[3];
        S[nt] = MFMA16(ak, bi, cc);
      }
    }
    if (EMIT) {
      __syncthreads();
#pragma unroll
      for (int nt = 0; nt < 4; ++nt) {
        uint2 pk; pk.x = pack2(S[nt][0], S[nt][1]); pk.y = pack2(S[nt][2], S[nt][3]);
        *(uint2*)(&sm.sST[(16 * nt + n16) * 72 + 16 * w + 4 * q4]) = pk;
      }
    }
  }
}

DI int hg_sidx(int seq, int h, int dir, int c) {
  return (seq < 32) ? ((seq * 4 + h) * 2 + dir) * 4 + c : 1024 + (((seq - 32) * 4 + h) * 2 + dir) * 32 + c;
}

DI void hgrn_summary(const Params& p, int l, int item, char* smem) {
  HgSmem& sm = *(HgSmem*)smem;
  const int tid = get_tid();
  int seq, h, dir, c;
  if (item < 1024) { c = item & 3; dir = (item >> 2) & 1; h = (item >> 3) & 3; seq = item >> 5; }
  else { int r = item - 1024; c = r & 31; dir = (r >> 5) & 1; h = (r >> 6) & 3; seq = 32 + (r >> 8); }
  const int tbase = (seq < 32) ? seq * 256 : NCTX + (seq - 32) * 2048;
  f32x4v S[4];
#pragma unroll
  for (int nt = 0; nt < 4; ++nt) { S[nt][0] = 0.f; S[nt][1] = 0.f; S[nt][2] = 0.f; S[nt][3] = 0.f; }
  float cdt;
  hgrn_chunk<false>(p, l, tbase, h, dir, c, S, cdt, sm, true);
  if (tid < 64) ((float*)(p.ws + W_HCD))[(size_t)item * 64 + tid] = cdt;
  float* kv = (float*)(p.ws + W_HKV) + (size_t)item * 4096;
#pragma unroll
  for (int nt = 0; nt < 4; ++nt) *(float4*)(kv + (nt * 256 + tid) * 4) = make_float4(S[nt][0], S[nt][1], S[nt][2], S[nt][3]);
  __syncthreads();
}

DI void hgrn_output(const Params& p, int l, int seq, int h, int c, char* smem) {
  HgSmem& sm = *(HgSmem*)smem;
  const int tid = get_tid(), lane = tid & 63, w = tid >> 6, n16 = lane & 15, q4 = lane >> 4;
  const bool ctx = seq < 32;
  const int NC = ctx ? 4 : 32;
  const int tbase = ctx ? seq * 256 : NCTX + (seq - 32) * 2048;
  const float* hkv = (const float*)(p.ws + W_HKV);
  const float* hcd = (const float*)(p.ws + W_HCD);
  const int k0 = 16 * w + 4 * q4;
  for (int dir = 0; dir < 2; ++dir) {
    f32x4v S[4];
    if (ctx) {
#pragma unroll
      for (int nt = 0; nt < 4; ++nt) { S[nt][0] = 0.f; S[nt][1] = 0.f; S[nt][2] = 0.f; S[nt][3] = 0.f; }
    } else {
      const float* s0 = p.in[I_SHG] + ((((size_t)(seq - 32) * 2 + l) * 2 + dir) * 4 + h) * 4096;
#pragma unroll
      for (int nt = 0; nt < 4; ++nt)
#pragma unroll
        for (int r = 0; r < 4; ++r) S[nt][r] = s0[(k0 + r) * 64 + 16 * nt + n16];
    }
    const int nprev = dir ? NC - 1 - c : c;
#pragma unroll 4
    for (int q = 0; q < nprev; ++q) {
      const int m = dir ? NC - 1 - q : q;
      const int si = hg_sidx(seq, h, dir, m);
      const float4 cd = *(const float4*)(hcd + (size_t)si * 64 + k0);
      const float* kv = hkv + (size_t)si * 4096;
#pragma unroll
      for (int nt = 0; nt < 4; ++nt) {
        const float4 t = *(const float4*)(kv + (nt * 256 + tid) * 4);
        S[nt][0] = S[nt][0] * cd.x + t.x; S[nt][1] = S[nt][1] * cd.y + t.y;
        S[nt][2] = S[nt][2] * cd.z + t.z; S[nt][3] = S[nt][3] * cd.w + t.w;
      }
    }
    float cdt;
    hgrn_chunk<true>(p, l, tbase, h, dir, c, S, cdt, sm, dir == 0);
    if (ctx && ((dir == 0 && c == NC - 1) || (dir == 1 && c == 0))) {
      float* so = p.out + O_HG + ((((size_t)seq * 2 + l) * 2 + dir) * 4 + h) * 4096;
#pragma unroll
      for (int nt = 0; nt < 4; ++nt)
#pragma unroll
        for (int r = 0; r < 4; ++r) so[(k0 + r) * 64 + 16 * nt + n16] = S[nt][r];
    }
  }
  __syncthreads();
  {
    const int pos = tid >> 2, part = tid & 3;
    const int t = tbase + c * 64 + pos;
    f32x16 o;
    float ss = 0.f;
#pragma unroll
    for (int i = 0; i < 16; ++i) { o[i] = sm.sO[pos * 64 + part * 16 + i]; ss += o[i] * o[i]; }
    ss += __shfl_xor(ss, 1); ss += __shfl_xor(ss, 2);
    const float sc = rsqrtf(ss * (1.f / 64.f) + EPS);
    const float* zg = (const float*)(p.ws + W_ZH) + (size_t)t * 1280 + 1024 + h * 64 + part * 16;
    const float* ng = p.in[I_HGN] + l * 64 + part * 16;
    bf16_t* mx = (bf16_t*)(p.ws + W_MIX) + (size_t)t * LDX + h * 64 + part * 16;
#pragma unroll
    for (int i4 = 0; i4 < 4; ++i4) {
      float4 r;
      r.x = o[i4 * 4 + 0] * sc * ng[i4 * 4 + 0] * silu(zg[i4 * 4 + 0]);
      r.y = o[i4 * 4 + 1] * sc * ng[i4 * 4 + 1] * silu(zg[i4 * 4 + 1]);
      r.z = o[i4 * 4 + 2] * sc * ng[i4 * 4 + 2] * silu(zg[i4 * 4 + 2]);
      r.w = o[i4 * 4 + 3] * sc * ng[i4 * 4 + 3] * silu(zg[i4 * 4 + 3]);
      store_bf4(mx + i4 * 4, r);
    }
  }
  __syncthreads();
}

DI void attn_dispatch(const Params& p, int type, int t0, int kr0, int nkeys, int h, char* smem);
DI void phase2(const Params& p, int l, char* smem) {
  char* ws = p.ws;
  __shared__ int s_pair2;
  unsigned* ctr = (unsigned*)(p.ws + W_BAR) + 3456 + (4 + l) * 16;
  const int half = get_half();
  for (;;) {
    __syncthreads();
    if (get_tid512() == 0) s_pair2 = (int)__hip_atomic_fetch_add(ctr, 1u, __ATOMIC_RELAXED, __HIP_MEMORY_SCOPE_AGENT);
    __syncthreads();
    const int pair = s_pair2;
    if (pair >= 1644) break;
    const int qi = pair * 2 + half;
    if (qi < 192) {
      const int b = qi / 96, h = (qi % 96) / 16, qb = qi % 16;
      attn_dispatch(p, 1, NCTX + b * 2048 + qb * 128, NCTX + b * 2304, 2304, h, smem);
      continue;
    }
    if (qi >= 2904) {
      const int i = qi - 2904;
      const int b = i / 12, h = (i % 12) / 2, qb = i % 2;
      attn_dispatch(p, 1, b * 256 + qb * 128, b * 256, 256, h, smem);
      continue;
    }
    const int it = (qi < 1728) ? 1176 + (qi - 192) : qi - 1728;
    if (it < 576) {
      const int mt = it / 6, h = it % 6, m0 = mt * 128;
      gemm_core((const bf16_t*)(ws + W_MQ) + (size_t)m0 * 256, 256,
                (const bf16_t*)(ws + W_WUQ) + ((size_t)l * 768 + h * 128) * 256, 256, 256, smem);
      const float* Cs = (const float*)smem;
      const int tid = get_tid(), cl = tid & 31, c4 = cl * 4, rr = tid >> 5;
      const float* mqss = (const float*)(ws + W_MQSS);
      for (int ps = 0; ps < 16; ++ps) {
        const int r = ps * 8 + rr, t = m0 + r;
        float4 v = *(const float4*)(Cs + r * CS + c4);
        const float sc = rsqrtf((mqss[t * 2] + mqss[t * 2 + 1]) * (1.f / 256.f) + EPS) * MLA_QS;
        v.x *= sc; v.y *= sc; v.z *= sc; v.w *= sc;
        float4 pv = shfl4(v, 2);
        if (t >= NCTX && c4 >= 64) {
          const int s = (t - NCTX) & 2047;
          const int d = c4 - 64, blk = (d >> 4) & 1, pd = d & 15;
          const int pos = (blk == 0) ? (s >> 6) : (s & 63);
          v = rope4(v, pv, pd & 7, pd < 8, pos, (const float*)(ws + W_ROPE) + 2048, 8);
        }
        if (c4 < 96) store_bf4((bf16_t*)(ws + W_QM) + (size_t)t * 576 + h * 96 + c4, v);
      }
      __syncthreads();
    } else if (it < 1176) {
      const int i2 = it - 576;
      const int mt = i2 / 6, h = i2 % 6, m0 = mt * 128;
      gemm_core((const bf16_t*)(ws + W_CKVB) + (size_t)m0 * 128, 128,
                (const bf16_t*)(ws + W_WUKV) + ((size_t)l * 768 + h * 128) * 128, 128, 128, smem);
      const float* Cs = (const float*)smem;
      const int tid = get_tid();
      {
        const int c8 = (tid & 7) * 8, rr = tid >> 3;
        for (int ps = 0; ps < 4; ++ps) {
          const int r = ps * 32 + rr;
          const float4 v0 = *(const float4*)(Cs + r * CS + c8), v1 = *(const float4*)(Cs + r * CS + c8 + 4);
          u32x4 pk; pk[0] = pack2(v0.x, v0.y); pk[1] = pack2(v0.z, v0.w); pk[2] = pack2(v1.x, v1.y); pk[3] = pack2(v1.z, v1.w);
          *(u32x4*)((bf16_t*)(ws + W_KM) + (size_t)(m0 + r) * 576 + h * 96 + c8) = pk;
        }
      }
      {
        bf16_t* vmt = (bf16_t*)(ws + W_VMT);
#pragma unroll 2
        for (int i = 0; i < 4; ++i) {
          const int idx = tid + 256 * i, rg = idx & 15, dv = idx >> 4;
          const float* cp = Cs + (rg * 8) * CS + 64 + dv;
          u32x4 pk;
          pk[0] = pack2(cp[0], cp[CS]); pk[1] = pack2(cp[2 * CS], cp[3 * CS]);
          pk[2] = pack2(cp[4 * CS], cp[5 * CS]); pk[3] = pack2(cp[6 * CS], cp[7 * CS]);
          *(u32x4*)(vmt + (size_t)(h * 64 + dv) * NKR + m0 + rg * 8) = pk;
        }
      }
      __syncthreads();
    } else {
      hgrn_summary(p, l, it - 1176, smem);
    }
  }
}

template <int DK>
DI void attn_item(const bf16_t* __restrict__ Qp, int qstride, const bf16_t* __restrict__ Kp, int kstride,
                  const bf16_t* __restrict__ Vtp, int nkeys, bf16_t* __restrict__ outp, char* smem) {
  constexpr int KSTR = (DK + 8) * 2;
  constexpr int KCH = DK / 8;
  constexpr int NKC = 64 * KCH / 256;
  const int tid = get_tid(), lane = tid & 63, w = tid >> 6, l32 = lane & 31, g = lane >> 5;
  char* Ks = smem;
  char* Vs = smem + 64 * KSTR;
  bf16x8 qf[DK / 16];
#pragma unroll
  for (int ks = 0; ks < DK / 16; ++ks) qf[ks] = *(const bf16x8*)(Qp + (size_t)(w * 32 + l32) * qstride + ks * 16 + g * 8);
  f32x16 O0, O1;
#pragma unroll
  for (int e = 0; e < 16; ++e) { O0[e] = 0.f; O1[e] = 0.f; }
  float m_run = -1e30f, l_part = 0.f;
  u32x16 rkA, rkB;
  u32x8 rvA, rvB;
  const int nkt = nkeys >> 6;
  constexpr int ABUF = 64 * KSTR + 64 * 144;
#define ATT_LOAD(RK, RV, key0)                                                                                     \
  {                                                                                                                \
    _Pragma("unroll") for (int i = 0; i < NKC; ++i) {                                                              \
      const int idx = tid + 256 * i, row = idx / KCH, ch = idx % KCH;                                              \
      const u32x4 t = *(const u32x4*)(Kp + (size_t)((key0) + row) * kstride + ch * 8);                             \
      RK[i * 4] = t[0]; RK[i * 4 + 1] = t[1]; RK[i * 4 + 2] = t[2]; RK[i * 4 + 3] = t[3];                          \
    }                                                                                                              \
    _Pragma("unroll") for (int i = 0; i < 2; ++i) {                                                                \
      const int idx = tid + 256 * i, row = idx >> 3, ch = idx & 7;                                                 \
      const u32x4 t = *(const u32x4*)(Vtp + (size_t)row * NKR + (key0) + ch * 8);                                  \
      RV[i * 4] = t[0]; RV[i * 4 + 1] = t[1]; RV[i * 4 + 2] = t[2]; RV[i * 4 + 3] = t[3];                          \
    }                                                                                                              \
  }
#define ATT_PUT(RK, RV, buf)                                                                                       \
  {                                                                                                                \
    _Pragma("unroll") for (int i = 0; i < NKC; ++i) {                                                              \
      const int idx = tid + 256 * i, row = idx / KCH, ch = idx % KCH;                                              \
      u32x4 t; t[0] = RK[i * 4]; t[1] = RK[i * 4 + 1]; t[2] = RK[i * 4 + 2]; t[3] = RK[i * 4 + 3];                 \
      *(u32x4*)(Ks + (buf) * ABUF + row * KSTR + ch * 16) = t;                                                     \
    }                                                                                                              \
    _Pragma("unroll") for (int i = 0; i < 2; ++i) {                                                                \
      const int idx = tid + 256 * i, row = idx >> 3, ch = idx & 7;                                                 \
      u32x4 t; t[0] = RV[i * 4]; t[1] = RV[i * 4 + 1]; t[2] = RV[i * 4 + 2]; t[3] = RV[i * 4 + 3];                 \
      *(u32x4*)(Vs + (buf) * ABUF + row * 144 + ch * 16) = t;                                                      \
    }                                                                                                              \
  }
  auto compute = [&](const char* Kc, const char* Vc) {
    f32x16 s0, s1;
#pragma unroll
    for (int e = 0; e < 16; ++e) { s0[e] = 0.f; s1[e] = 0.f; }
#pragma unroll
    for (int ks = 0; ks < DK / 16; ++ks) {
      bf16x8 a0 = *(const bf16x8*)(Kc + l32 * KSTR + (ks * 16 + g * 8) * 2);
      bf16x8 a1 = *(const bf16x8*)(Kc + (32 + l32) * KSTR + (ks * 16 + g * 8) * 2);
      s0 = MFMA(a0, qf[ks], s0);
      s1 = MFMA(a1, qf[ks], s1);
    }
    float mx = s0[0];
#pragma unroll
    for (int e = 0; e < 16; ++e) { mx = fmaxf(mx, s0[e]); mx = fmaxf(mx, s1[e]); }
    mx = fmaxf(mx, __shfl_xor(mx, 32));
    const float mnew = fmaxf(m_run, mx);
    const float alpha = fexp2(m_run - mnew);
    m_run = mnew;
    float ps = 0.f;
#pragma unroll
    for (int e = 0; e < 16; ++e) { s0[e] = fexp2(s0[e] - mnew); s1[e] = fexp2(s1[e] - mnew); ps += s0[e] + s1[e]; }
    l_part = l_part * alpha + ps;
#pragma unroll
    for (int e = 0; e < 16; ++e) { O0[e] *= alpha; O1[e] *= alpha; }
#pragma unroll
    for (int mt = 0; mt < 2; ++mt) {
#pragma unroll
      for (int hh = 0; hh < 2; ++hh) {
        u32x4 pfu;
#pragma unroll
        for (int e = 0; e < 4; ++e) {
          const float x0 = mt ? s1[hh * 8 + 2 * e] : s0[hh * 8 + 2 * e];
          const float x1 = mt ? s1[hh * 8 + 2 * e + 1] : s0[hh * 8 + 2 * e + 1];
          pfu[e] = pack2(x0, x1);
        }
        const bf16x8 pf = __builtin_bit_cast(bf16x8, pfu);
        const int kb = (mt * 32 + hh * 16 + 4 * g) * 2;
        const u32x2 va = *(const u32x2*)(Vc + l32 * 144 + kb), vb = *(const u32x2*)(Vc + l32 * 144 + kb + 16);
        const u32x2 vc = *(const u32x2*)(Vc + (32 + l32) * 144 + kb), vd = *(const u32x2*)(Vc + (32 + l32) * 144 + kb + 16);
        u32x4 v0u, v1u;
        v0u[0] = va[0]; v0u[1] = va[1]; v0u[2] = vb[0]; v0u[3] = vb[1];
        v1u[0] = vc[0]; v1u[1] = vc[1]; v1u[2] = vd[0]; v1u[3] = vd[1];
        O0 = MFMA(__builtin_bit_cast(bf16x8, v0u), pf, O0);
        O1 = MFMA(__builtin_bit_cast(bf16x8, v1u), pf, O1);
      }
    }
  };
  ATT_LOAD(rkA, rvA, 0)
  ATT_PUT(rkA, rvA, 0)
  ATT_LOAD(rkA, rvA, 64)
  if (nkt > 2) ATT_LOAD(rkB, rvB, 128)
  __syncthreads();
  for (int kt = 0; kt < nkt; kt += 2) {
    __builtin_amdgcn_sched_barrier(0);
    compute(Ks, Vs);
    __builtin_amdgcn_sched_barrier(0);
    ATT_PUT(rkA, rvA, 1)
    if (kt + 3 < nkt) { const int k3 = (kt + 3) << 6; ATT_LOAD(rkA, rvA, k3) }
    __syncthreads();
    __builtin_amdgcn_sched_barrier(0);
    compute(Ks + ABUF, Vs + ABUF);
    __builtin_amdgcn_sched_barrier(0);
    if (kt + 2 < nkt) ATT_PUT(rkB, rvB, 0)
    if (kt + 4 < nkt) { const int k4 = (kt + 4) << 6; ATT_LOAD(rkB, rvB, k4) }
    __syncthreads();
  }
  const float lt = l_part + __shfl_xor(l_part, 32);
  const float inv = 1.f / lt;
  bf16_t* orow = outp + (size_t)(w * 32 + l32) * LDX;
#pragma unroll
  for (int j4 = 0; j4 < 4; ++j4) {
    store_bf4(orow + 8 * j4 + 4 * g, make_float4(O0[j4 * 4] * inv, O0[j4 * 4 + 1] * inv, O0[j4 * 4 + 2] * inv, O0[j4 * 4 + 3] * inv));
    store_bf4(orow + 32 + 8 * j4 + 4 * g, make_float4(O1[j4 * 4] * inv, O1[j4 * 4 + 1] * inv, O1[j4 * 4 + 2] * inv, O1[j4 * 4 + 3] * inv));
  }
}

DI void attn_dispatch(const Params& p, int type, int t0, int kr0, int nkeys, int h, char* smem) {
  char* ws = p.ws;
  bf16_t* mix = (bf16_t*)(ws + W_MIX) + (size_t)t0 * LDX;
  if (type == 0) {
    attn_item<96>((const bf16_t*)(ws + W_QM) + (size_t)t0 * 576 + h * 96, 576, (const bf16_t*)(ws + W_KM) + (size_t)kr0 * 576 + h * 96, 576,
                  (const bf16_t*)(ws + W_VMT) + (size_t)(h * 64) * NKR + kr0, nkeys, mix + 256 + h * 64, smem);
  } else {
    const int kvh = h / 3;
    attn_item<64>((const bf16_t*)(ws + W_QG) + (size_t)t0 * 384 + h * 64, 384, (const bf16_t*)(ws + W_KG) + (size_t)kr0 * 128 + kvh * 64, 128,
                  (const bf16_t*)(ws + W_VGT) + (size_t)(kvh * 64) * NKR + kr0, nkeys, mix + 640 + h * 64, smem);
  }
}

DI void phase3(const Params& p, int l, char* smem) {
  __shared__ int s_pair;
  unsigned* ctr = (unsigned*)(p.ws + W_BAR) + 3456 + l * 16;
  const int half = get_half();
  for (;;) {
    __syncthreads();
    if (get_tid512() == 0) s_pair = (int)__hip_atomic_fetch_add(ctr, 1u, __ATOMIC_RELAXED, __HIP_MEMORY_SCOPE_AGENT);
    __syncthreads();
    const int pair = s_pair;
    if (pair >= 672) break;
    const int qi = pair * 2 + half;
    if (qi < 256) {
      hgrn_output(p, l, 32 + qi / 128, (qi % 128) / 32, qi % 32, smem);
    } else if (qi < 448) {
      const int r = qi - 256, b = r / 96, h = (r % 96) / 16, qb = r % 16;
      attn_dispatch(p, 0, NCTX + b * 2048 + qb * 128, NCTX + b * 2304, 2304, h, smem);
    } else if (qi < 960) {
      const int i = qi - 448;
      hgrn_output(p, l, i / 16, (i % 16) / 4, i % 4, smem);
    } else {
      const int r = qi - 960, b = r / 12, h = (r % 12) / 2, qb = r % 2;
      attn_dispatch(p, 0, b * 256 + qb * 128, b * 256, 256, h, smem);
    }
  }
}

template <int WHICH>
DI void phase46(const Params& p, int l, char* smem) {
  char* ws = p.ws;
  const float* am = (const float*)(ws + W_ADAM);
  TileWalk512 tw(64, 4);
  int mt, nt2;
  const int hf = get_half();
  while (tw.next(mt, nt2)) {
    const int mbase = mt * 192, n0 = nt2 * 256 + hf * 128;
    f32x16 acc[3][2];
    if (WHICH == 4)
      gemm512_main<3>((const bf16_t*)(ws + W_MIX) + (size_t)mbase * LDX, LDX,
                   (const bf16_t*)(ws + W_WOUT) + ((size_t)l * 1024 + nt2 * 256) * LDX, LDX, 1024, smem, acc);
    else
      gemm512_main<3>((const bf16_t*)(ws + W_HID) + (size_t)mbase * LDH, LDH,
                   (const bf16_t*)(ws + W_WFO) + ((size_t)l * 1024 + nt2 * 256) * LDH, LDH, 2816, smem, acc);
#pragma nounroll
    for (int hh = 0; hh < 2; ++hh) {
    const int m0 = mbase + hh * 96;
    gemm512_stage<3>(acc, hh, smem);
    const int va = (m0 < NCTX) ? 0 : 1 + ((m0 - NCTX) >> 11), vb2 = (m0 + 95 < NCTX) ? 0 : 1 + ((m0 + 95 - NCTX) >> 11);
    const float* Cs = (const float*)(smem + hf * STG);
    const int tid = get_tid(), cl = tid & 31, c4 = cl * 4, rr = tid >> 5;
    const int c = n0 + c4;
    const float4 gateA = *(const float4*)(am + (l * 3 + va) * 6144 + (WHICH == 4 ? 2048 : 5120) + c);
    const float4 gateB = *(const float4*)(am + (l * 3 + vb2) * 6144 + (WHICH == 4 ? 2048 : 5120) + c);
    float4 lg = make_float4(1.f, 1.f, 1.f, 1.f), lb = make_float4(0.f, 0.f, 0.f, 0.f);
    bool ln = true;
    if (WHICH == 4) {
      if (l == 0) ln = false;
      else { lg = *(const float4*)(p.in[I_LN2G] + c); lb = *(const float4*)(p.in[I_LN2B] + c); }
    } else {
      lg = *(const float4*)(p.in[I_LN1G] + l * 1024 + c); lb = *(const float4*)(p.in[I_LN1B] + l * 1024 + c);
    }
    const float* st = (const float*)(ws + (WHICH == 4 ? W_STB : W_STA));
    for (int pb = 0; pb < 12; pb += 2) {
      f32x8 xr;
      f32x4 sr;
#pragma unroll
      for (int u = 0; u < 2; ++u) {
        const int t = m0 + (pb + u) * 8 + rr;
        const float* xp;
        if (WHICH == 4 && l == 0) xp = ((t < NCTX) ? p.in[I_XP] + (size_t)t * 1024 : p.in[I_XS] + (size_t)(t - NCTX) * 1024) + c;
        else xp = p.out + (size_t)t * 1024 + c;
        const f32x4 t4 = *(const f32x4*)xp;
        xr[u * 4] = t4[0]; xr[u * 4 + 1] = t4[1]; xr[u * 4 + 2] = t4[2]; xr[u * 4 + 3] = t4[3];
        if (ln) { sr[u * 2] = ld_dev(st + t * 32); sr[u * 2 + 1] = ld_dev(st + t * 32 + 1); }
        else { sr[u * 2] = 0.f; sr[u * 2 + 1] = 1.f; }
      }
#pragma unroll
      for (int u = 0; u < 2; ++u) {
        const int r = (pb + u) * 8 + rr, t = m0 + r;
        const float4 y = *(const float4*)(Cs + r * CS + c4);
        float4 x = make_float4(xr[u * 4], xr[u * 4 + 1], xr[u * 4 + 2], xr[u * 4 + 3]);
        if (ln) {
          const float mean = sr[u * 2], rstd = sr[u * 2 + 1];
          x.x = (x.x - mean) * rstd * lg.x + lb.x; x.y = (x.y - mean) * rstd * lg.y + lb.y;
          x.z = (x.z - mean) * rstd * lg.z + lb.z; x.w = (x.w - mean) * rstd * lg.w + lb.w;
        }
        const int vrow = (t < NCTX) ? 0 : 1 + ((t - NCTX) >> 11);
        const float4 gate = (vrow == va) ? gateA : gateB;
        float4 o;
        o.x = ALPHA * x.x + gate.x * y.x; o.y = ALPHA * x.y + gate.y * y.y;
        o.z = ALPHA * x.z + gate.z * y.z; o.w = ALPHA * x.w + gate.w * y.w;
        *(float4*)(p.out + (size_t)t * 1024 + c) = o;
      }
    }
    __syncthreads();
    }
  }
}

DI void phase_rowprep(const Params& p, int l, int which) {
  const int lane = get_tid() & 63;
  const int gw = vbid() * 4 + (get_tid() >> 6), nw = vgrid() * 4;
  const bool ln = !(which == 0 && l == 0);
  float* st = (float*)(p.ws + (which == 0 ? W_STB : W_STA));
  bf16_t* hb = (bf16_t*)(p.ws + W_MIX);
  for (int t = gw; t < NTOK; t += nw) {
    const int v = (t < NCTX) ? 0 : 1 + ((t - NCTX) >> 11);
    const float* row;
    if (!ln) row = (t < NCTX) ? p.in[I_XP] + (size_t)t * 1024 : p.in[I_XS] + (size_t)(t - NCTX) * 1024;
    else row = p.out + (size_t)t * 1024;
    const float* gb = (const float*)(p.ws + W_GB) + ((l * 2 + which) * 3 + v) * 2048;
    f32x16 x;
    float s = 0.f;
#pragma unroll
    for (int i = 0; i < 4; ++i) {
      const f32x4 t4 = *(const f32x4*)(row + i * 256 + lane * 4);
      x[i * 4] = t4[0]; x[i * 4 + 1] = t4[1]; x[i * 4 + 2] = t4[2]; x[i * 4 + 3] = t4[3];
      s += t4[0] + t4[1] + t4[2] + t4[3];
    }
    float rstd = 1.f;
    if (ln) {
#pragma unroll
      for (int m = 1; m < 64; m <<= 1) s += __shfl_xor(s, m);
      const float mean = s * (1.f / 1024.f);
      float s2 = 0.f;
#pragma unroll
      for (int i = 0; i < 16; ++i) { x[i] -= mean; s2 += x[i] * x[i]; }
#pragma unroll
      for (int m = 1; m < 64; m <<= 1) s2 += __shfl_xor(s2, m);
      rstd = rsqrtf(s2 * (1.f / 1024.f) + EPS);
      if (lane == 0) { st[t * 32] = mean; st[t * 32 + 1] = rstd; }
    }
#pragma unroll
    for (int i = 0; i < 4; ++i) {
      const float4 gg = *(const float4*)(gb + i * 256 + lane * 4), bb = *(const float4*)(gb + 1024 + i * 256 + lane * 4);
      store_bf4(hb + (size_t)t * LDX + i * 256 + lane * 4,
                make_float4(x[i * 4] * rstd * gg.x + bb.x, x[i * 4 + 1] * rstd * gg.y + bb.y, x[i * 4 + 2] * rstd * gg.z + bb.z, x[i * 4 + 3] * rstd * gg.w + bb.w));
    }
  }
}

DI void phase5(const Params& p, int l, char* smem) {
  char* ws = p.ws;
  const int hf = get_half();
  auto epilogue = [&](int m0, int nt, const float* Cs, int npass) {
    const int tid = get_tid(), q = (tid & 15) * 4, rr = tid >> 4;
    const int grp = q >> 5, jj = q & 31;
    bf16_t* hid = (bf16_t*)(ws + W_HID);
    for (int ps = 0; ps < npass; ++ps) {
      const int r = ps * 16 + rr, t = m0 + r;
      const float4 gt = *(const float4*)(Cs + r * CS + grp * 64 + jj);
      const float4 up = *(const float4*)(Cs + r * CS + grp * 64 + 32 + jj);
      float4 o = make_float4(silu(gt.x) * up.x, silu(gt.y) * up.y, silu(gt.z) * up.z, silu(gt.w) * up.w);
      store_bf4(hid + (size_t)t * LDH + nt * 64 + q, o);
    }
  };
  const int x = blockIdx.x & 7, j = blockIdx.x >> 3, nb = gridDim.x >> 3;
  const int mtx = (48 - x + 7) >> 3, total = mtx * 22;
  const int full = (total / nb) * nb;
  for (int q = j; q < full; q += nb) {
    const int mt = (q % mtx) * 8 + x, nt2 = q / mtx;
    const int mbase = mt * 256;
    const int nt = nt2 * 2 + hf;
    f32x16 acc[4][2];
    gemm512_main<4>((const bf16_t*)(ws + W_MIX) + (size_t)mbase * LDX, LDX,
                    (const bf16_t*)(ws + W_WFI) + ((size_t)l * 5632 + nt2 * 256) * LDX, LDX, 1024, smem, acc);
#pragma nounroll
    for (int hh = 0; hh < 2; ++hh) {
      gemm512_stage<4>(acc, hh, smem);
      epilogue(mbase + hh * 128, nt, (const float*)(smem + hf * STG), 8);
      __syncthreads();
    }
  }
  for (int jq = j; jq < 4 * (total - full); jq += nb) {
    const int q = full + (jq >> 2);
    const int mt = (q % mtx) * 8 + x, nt2 = q / mtx;
    const int mbase = mt * 256 + (jq & 3) * 64;
    const int nt = nt2 * 2 + hf;
    f32x16 acc[1][2];
    gemm512_main<1>((const bf16_t*)(ws + W_MIX) + (size_t)mbase * LDX, LDX,
                    (const bf16_t*)(ws + W_WFI) + ((size_t)l * 5632 + nt2 * 256) * LDX, LDX, 1024, smem, acc);
#pragma nounroll
    for (int hh = 0; hh < 2; ++hh) {
      gemm512_stage<1>(acc, hh, smem);
      epilogue(mbase + hh * 32, nt, (const float*)(smem + hf * STG), 2);
      __syncthreads();
    }
  }
}

DI void phase7(const Params& p) {
  const int lane = get_tid() & 63;
  const int gw = vbid() * 4 + (get_tid() >> 6), nw = vgrid() * 4;
  const float* g = p.in[I_LN2G] + 1024;
  const float* b = p.in[I_LN2B] + 1024;
  for (int t = gw; t < NTOK; t += nw) {
    float* row = p.out + (size_t)t * 1024;
    f32x16 x;
    float s = 0.f;
#pragma unroll
    for (int i = 0; i < 4; ++i) {
      const f32x4 t4 = *(const f32x4*)(row + i * 256 + lane * 4);
      x[i * 4] = t4[0]; x[i * 4 + 1] = t4[1]; x[i * 4 + 2] = t4[2]; x[i * 4 + 3] = t4[3];
      s += t4[0] + t4[1] + t4[2] + t4[3];
    }
#pragma unroll
    for (int m = 1; m < 64; m <<= 1) s += __shfl_xor(s, m);
    const float mean = s * (1.f / 1024.f);
    float s2 = 0.f;
#pragma unroll
    for (int i = 0; i < 16; ++i) { x[i] -= mean; s2 += x[i] * x[i]; }
#pragma unroll
    for (int m = 1; m < 64; m <<= 1) s2 += __shfl_xor(s2, m);
    const float rstd = rsqrtf(s2 * (1.f / 1024.f) + EPS);
#pragma unroll
    for (int i = 0; i < 4; ++i) {
      const float4 gg = *(const float4*)(g + i * 256 + lane * 4), bb = *(const float4*)(b + i * 256 + lane * 4);
      float4 o = make_float4(x[i * 4] * rstd * gg.x + bb.x, x[i * 4 + 1] * rstd * gg.y + bb.y, x[i * 4 + 2] * rstd * gg.z + bb.z, x[i * 4 + 3] * rstd * gg.w + bb.w);
      *(float4*)(row + i * 256 + lane * 4) = o;
    }
  }
}

constexpr int NPHASE = 19;
DI void run_phase(const Params& p, int ph, char* smem) {
  char* smh = smem + get_half() * STG;
  if (ph == 0) phase0(p, smh);
  else if (ph == 1) phase0b(p);
  else if (ph == NPHASE - 1) phase7(p);
  else {
    const int l = (ph - 2) >> 3, s = (ph - 2) & 7;
    if (s == 0) { if (l == 0) wprep_all(p, smh); phase_rowprep(p, l, 0); }
    else if (s == 1) phase1(p, l, smem);
    else if (s == 2) phase2(p, l, smh);
    else if (s == 3) phase3(p, l, smh);
    else if (s == 4) phase46<4>(p, l, smem);
    else if (s == 5) phase_rowprep(p, l, 1);
    else if (s == 6) phase5(p, l, smem);
    else phase46<6>(p, l, smem);
  }
}

#define XB_TMO      128
#define XB_XCNT(j)  (256  + 64 * (j))
#define XB_XSUB(j)  (1280 + 64 * (j))
#define XB_XGEN(j)  (2304 + 64 * (j))
#define XB_TOP      3328
#define XB_TOPGEN   3392
#define XCD_BAR_WORDS 3456
#define XB_SPIN_CAP (1u << 22)
#define LAS __attribute__((address_space(3)))
DI unsigned xb_ld(unsigned* p) { return __hip_atomic_load(p, __ATOMIC_RELAXED, __HIP_MEMORY_SCOPE_AGENT); }
DI unsigned xb_add(unsigned* p, unsigned v) { return __hip_atomic_fetch_add(p, v, __ATOMIC_RELAXED, __HIP_MEMORY_SCOPE_AGENT); }
DI unsigned xb_xcc_id() { return (unsigned)__builtin_amdgcn_s_getreg((3 << 11) | 20) & 0xFu; }
#define XB_SPIN(cond, bar) do { unsigned _sp = 0; while (cond) { __builtin_amdgcn_s_sleep(1); \
    if ((++_sp & 255u) == 0u) { if (xb_ld(&(bar)[XB_TMO])) break; if (_sp > XB_SPIN_CAP) { atomicAdd(&(bar)[XB_TMO], 1u); break; } } } } while (0)
struct XcdBarrier { unsigned* bar; unsigned x; volatile LAS unsigned* st; };
DI XcdBarrier xcd_barrier_post(unsigned* bar, volatile LAS unsigned* st) {
  XcdBarrier b; b.bar = bar; b.x = xb_xcc_id(); b.st = st;
  if (__builtin_amdgcn_workitem_id_x() == 0) (void)xb_add(&bar[XB_XCNT(b.x)], 1u);
  return b;
}
DI void xcd_barrier_complete(unsigned* bar, unsigned x, unsigned& nloc, unsigned& nx) {
  const unsigned G = gridDim.x * gridDim.y * gridDim.z;
  unsigned sum, cnt, mine, sp = 0u;
  for (;;) {
    sum = 0u; cnt = 0u; mine = 0u;
#pragma unroll
    for (unsigned j = 0; j < 16; ++j) { const unsigned c = xb_ld(&bar[XB_XCNT(j)]); sum += c; cnt += (c > 0u) ? 1u : 0u; mine = (j == x) ? c : mine; }
    if (sum == G) break;
    __builtin_amdgcn_s_sleep(1);
    if ((++sp & 255u) == 0u) { if (xb_ld(&bar[XB_TMO])) break; if (sp > XB_SPIN_CAP) { atomicAdd(&bar[XB_TMO], 1u); break; } }
  }
  nloc = mine > 0u ? mine : 1u; nx = cnt > 0u ? cnt : 1u;
}
DI void xcd_barrier(const XcdBarrier& b) {
  asm volatile("s_waitcnt vmcnt(0)" ::: "memory");
  __syncthreads();
  if (__builtin_amdgcn_workitem_id_x() == 0) {
    unsigned* bar = b.bar;
    __builtin_amdgcn_s_waitcnt(0);
    unsigned nloc = b.st[0], nx = b.st[1];
    if (nloc == 0u) { xcd_barrier_complete(bar, b.x, nloc, nx); b.st[0] = nloc; b.st[1] = nx; }
    const unsigned old = xb_add(&bar[XB_XSUB(b.x)], 1u);
    const unsigned gen = old / nloc;
    if (old + 1u == (gen + 1u) * nloc) {
      __builtin_amdgcn_fence(__ATOMIC_RELEASE, "agent");
      asm volatile("s_waitcnt vmcnt(0)" ::: "memory");
      const unsigned og = xb_add(&bar[XB_TOP], 1u);
      const unsigned tg = og / nx;
      if (og + 1u == (tg + 1u) * nx) xb_add(&bar[XB_TOPGEN], 1u);
      else XB_SPIN(xb_ld(&bar[XB_TOPGEN]) == tg, bar);
      __builtin_amdgcn_fence(__ATOMIC_ACQUIRE, "agent");
      xb_add(&bar[XB_XGEN(b.x)], 1u);
      asm volatile("s_waitcnt vmcnt(0)" ::: "memory");
    } else {
      XB_SPIN(xb_ld(&bar[XB_XGEN(b.x)]) == gen, bar);
      __builtin_amdgcn_fence(__ATOMIC_ACQUIRE, "agent");
      asm volatile("s_waitcnt vmcnt(0)" ::: "memory");
    }
  }
  __syncthreads();
}

#if !MULTI
__global__ void __launch_bounds__(512) mega_kernel(Params p) {
  __shared__ __attribute__((aligned(16))) char smem[2 * STG];
  __shared__ uint4 xb_words;
  cg::grid_group grid = cg::this_grid();
  if (p.ws == nullptr) grid.sync();
  if (__builtin_amdgcn_workitem_id_x() == 0) xb_words = make_uint4(0u, 0u, 0u, 0u);
  __syncthreads();
  const XcdBarrier xb = xcd_barrier_post((unsigned*)(p.ws + W_BAR), (volatile LAS unsigned*)&xb_words);
#pragma nounroll
  for (int ph = 0; ph < NPHASE; ++ph) {
    long zoff;
    asm volatile("s_mov_b64 %0, 0" : "=s"(zoff));
    Params q;
#pragma unroll
    for (int i = 0; i < 27; ++i) q.in[i] = (const float*)((const char*)p.in[i] + zoff);
    q.out = (float*)((char*)p.out + zoff);
    q.ws = p.ws + zoff;
    run_phase(q, ph, smem);
    if (ph < NPHASE - 1) xcd_barrier(xb);
  }
}
#endif

extern "C" void kernel_launch(void* const* d_in, const int* in_sizes, int n_in, void* d_out, int out_size, void* d_ws,
                              size_t ws_size, hipStream_t stream) {
  Params p{};
  for (int i = 0; i < 27; ++i) p.in[i] = (const float*)d_in[i];
  p.out = (float*)d_out;
  p.ws = (char*)d_ws;
#if MULTI
  for (int ph = 0; ph < NPHASE; ++ph) hipLaunchKernelGGL(phase_kernel, dim3(512), dim3(256), 0, stream, p, ph);
#else
  static int grid_blocks = 0;
  if (!grid_blocks) {
    int dev = 0, cus = 0, per_cu = 0;
    hipGetDevice(&dev);
    hipDeviceGetAttribute(&cus, hipDeviceAttributeMultiprocessorCount, dev);
    hipOccupancyMaxActiveBlocksPerMultiprocessor(&per_cu, mega_kernel, 512, 0);
    if (per_cu > 1) per_cu = 1;
    grid_blocks = cus * per_cu;
  }
  hipMemsetAsync((char*)d_ws + W_BAR, 0, BAR_BYTES, stream);
  void* args[] = {&p};
  hipError_t e = hipLaunchCooperativeKernel((void*)mega_kernel, dim3(grid_blocks), dim3(512), args, 0, stream);
  if (e != hipSuccess) fprintf(stderr, "cooperative launch failed: %s (grid %d)\n", hipGetErrorString(e), grid_blocks);
#endif
}
```
